# Optimizing an MI355X kernel written in HIP

```python
import math
import jax, jax.numpy as jnp
from jax import lax
import numpy as np

D_MODEL = 1024
BATCH = 8
SEQ = 8192
DEPTH = 1

N_META = 16
BLOCK = 128
META_PAD = (-N_META) % BLOCK
MLA_HEADS = 4
QK_NOPE = 128
QK_ROPE = 64
V_DIM = 128
Q_LORA = 256
KV_LORA = 256
ROPE_THETA = 10000.0
SB_HEADS = 8
SB_DIM = 64
MLA_W = MLA_HEADS * V_DIM
SB_W = SB_HEADS * SB_DIM
MIX_W = MLA_W + SB_W
IN_SPLITS = (Q_LORA, KV_LORA, QK_ROPE, SB_W, SB_W, SB_W)
IN_W = Q_LORA + KV_LORA + QK_ROPE + 3 * SB_W
N_EXPERTS = 32
TOP_K = 4
D_FF = 1024
SWIGLU_LIMIT = 7.0
SWIGLU_ALPHA = 1.702
EXPERT_BLOCK = 256
DN_ALPHA = (2 * DEPTH) ** 0.25
DN_BETA = (8 * DEPTH) ** -0.25
LN_EPS = 1e-5
RMS_EPS = 1e-6
NEG_INF = -1e30

kernel_name = 'hybrid_mla_stickbreak_moe_deepnorm'


def rms_norm(x, g):
    xf = x.astype(jnp.float32)
    y = xf * lax.rsqrt(jnp.mean(xf * xf, axis=-1, keepdims=True) + RMS_EPS) * g.astype(jnp.float32)
    return y.astype(x.dtype)


def layer_norm(x, g, b):
    xf = x.astype(jnp.float32)
    mu = jnp.mean(xf, axis=-1, keepdims=True)
    xc = xf - mu
    var = jnp.mean(xc * xc, axis=-1, keepdims=True)
    y = xc * lax.rsqrt(var + LN_EPS) * g.astype(jnp.float32) + b.astype(jnp.float32)
    return y.astype(x.dtype)


def rope_tables(length):
    half = QK_ROPE // 2
    freqs = ROPE_THETA ** (-jnp.arange(half, dtype=jnp.float32) * 2.0 / QK_ROPE)
    ang = jnp.arange(length, dtype=jnp.float32)[:, None] * freqs[None, :]
    return jnp.cos(ang)[:, None, :], jnp.sin(ang)[:, None, :]


def rope(x, cos, sin):
    half = x.shape[-1] // 2
    x1 = x[..., :half].astype(jnp.float32)
    x2 = x[..., half:].astype(jnp.float32)
    return jnp.concatenate([x1 * cos - x2 * sin, x2 * cos + x1 * sin], axis=-1).astype(x.dtype)


def to_blocks(t):
    b, lp, h, d = t.shape
    return t.reshape(b, lp // BLOCK, BLOCK, h, d).transpose(1, 0, 2, 3, 4)


def from_blocks(t):
    nb, b, q, h, d = t.shape
    return t.transpose(1, 0, 2, 3, 4).reshape(b, nb * q, h, d)


def mla_attention(q, k, v):
    lp = q.shape[1]
    k_pos = jnp.arange(lp)
    scale = (QK_NOPE + QK_ROPE) ** -0.5

    def one_block(args):
        qb, bi = args
        q_pos = bi * BLOCK + jnp.arange(BLOCK)
        valid = (k_pos[None, :] <= q_pos[:, None]) & (k_pos[None, :] >= META_PAD)
        s = jnp.einsum('bqhd,bkhd->bhqk', qb, k).astype(jnp.float32) * scale
        p = jax.nn.softmax(jnp.where(valid, s, NEG_INF), axis=-1)
        return jnp.einsum('bhqk,bkhd->bqhd', p.astype(v.dtype), v)

    out = lax.map(one_block, (to_blocks(q), jnp.arange(lp // BLOCK)))
    return from_blocks(out)


def stick_breaking_attention(q, k, v):
    lp = q.shape[1]
    k_pos = jnp.arange(lp)
    scale = SB_DIM ** -0.5

    def one_block(args):
        qb, bi = args
        q_pos = bi * BLOCK + jnp.arange(BLOCK)
        valid = (k_pos[None, :] < q_pos[:, None]) & (k_pos[None, :] >= META_PAD)
        z = jnp.einsum('bqhd,bkhd->bhqk', qb, k).astype(jnp.float32) * scale
        log_keep = jnp.where(valid, jax.nn.log_sigmoid(-z), 0.0)
        later = lax.cumsum(log_keep, axis=3, reverse=True) - log_keep
        w = jnp.where(valid, jnp.exp(jax.nn.log_sigmoid(z) + later), 0.0)
        return jnp.einsum('bhqk,bkhd->bqhd', w.astype(v.dtype), v)

    out = lax.map(one_block, (to_blocks(q), jnp.arange(lp // BLOCK)))
    return from_blocks(out)


def token_mixing(h, cos, sin, w_in, q_norm_g, w_uq, kv_norm_g, w_ukv, mla_out_g, sb_out_g, w_o):
    b, l, _ = h.shape
    split_at = np.cumsum(IN_SPLITS)[:-1].tolist()
    c_q, c_kv, k_r, sb_q, sb_k, sb_v = jnp.split(h @ w_in, split_at, axis=-1)
    q = (rms_norm(c_q, q_norm_g) @ w_uq).reshape(b, l, MLA_HEADS, QK_NOPE + QK_ROPE)
    q = jnp.concatenate([q[..., :QK_NOPE], rope(q[..., QK_NOPE:], cos, sin)], axis=-1)
    kv = (rms_norm(c_kv, kv_norm_g) @ w_ukv).reshape(b, l, MLA_HEADS, QK_NOPE + V_DIM)
    k_rope = rope(k_r.reshape(b, l, 1, QK_ROPE), cos, sin)
    k = jnp.concatenate([kv[..., :QK_NOPE], jnp.broadcast_to(k_rope, (b, l, MLA_HEADS, QK_ROPE))], axis=-1)
    v = kv[..., QK_NOPE:]

    def pad(t):
        return jnp.pad(t, ((0, 0), (META_PAD, 0), (0, 0), (0, 0)))

    o_mla = mla_attention(pad(q), pad(k), pad(v))[:, META_PAD:].reshape(b, l, MLA_W)
    sq = sb_q.reshape(b, l, SB_HEADS, SB_DIM)
    sk = sb_k.reshape(b, l, SB_HEADS, SB_DIM)
    sv = sb_v.reshape(b, l, SB_HEADS, SB_DIM)
    o_sb = stick_breaking_attention(pad(sq), pad(sk), pad(sv))[:, META_PAD:].reshape(b, l, SB_W)
    o = jnp.concatenate([rms_norm(o_mla, mla_out_g), rms_norm(o_sb, sb_out_g)], axis=-1)
    return o @ w_o


def moe_ffn(h, w_router, b_router, w_gate, b_gate, w_up, b_up, w_down, b_down):
    t, d = h.shape
    tk = t * TOP_K
    logits = (h @ w_router + b_router).astype(jnp.float32)
    top_v, top_i = lax.top_k(logits, TOP_K)
    gates = jax.nn.softmax(top_v, axis=-1).astype(h.dtype)
    flat_e = top_i.reshape(tk)
    order = jnp.argsort(flat_e)
    s_e = flat_e[order]
    s_tok = order // TOP_K
    s_gate = gates.reshape(tk)[order]
    counts = jnp.bincount(flat_e, length=N_EXPERTS)
    padded = (counts + EXPERT_BLOCK - 1) // EXPERT_BLOCK * EXPERT_BLOCK
    start = jnp.cumsum(counts) - counts
    p_end = jnp.cumsum(padded)
    p_start = p_end - padded
    dest = p_start[s_e] + jnp.arange(tk) - start[s_e]
    n_blk = (tk + N_EXPERTS * (EXPERT_BLOCK - 1) + EXPERT_BLOCK - 1) // EXPERT_BLOCK
    buf = jnp.zeros((n_blk * EXPERT_BLOCK, d), h.dtype).at[dest].set(h[s_tok])
    blk_e = jnp.minimum(jnp.sum(jnp.arange(n_blk)[:, None] * EXPERT_BLOCK >= p_end[None, :], axis=1), N_EXPERTS - 1)

    def expert_block(args):
        xb, e = args
        g = jnp.minimum(xb @ w_gate[e] + b_gate[e], SWIGLU_LIMIT)
        u = jnp.clip(xb @ w_up[e] + b_up[e], -SWIGLU_LIMIT, SWIGLU_LIMIT)
        a = (u + 1.0) * (g * jax.nn.sigmoid(SWIGLU_ALPHA * g))
        return a @ w_down[e] + b_down[e]

    y_buf = lax.map(expert_block, (buf.reshape(n_blk, EXPERT_BLOCK, d), blk_e)).reshape(n_blk * EXPERT_BLOCK, d)
    y = y_buf[dest] * s_gate[:, None]
    return jax.ops.segment_sum(y, s_tok, num_segments=t)


def setup_inputs(seed: int = 0) -> dict:
    key = jax.random.key(seed)
    ks = jax.random.split(key, 24)
    f32 = jnp.float32

    def nrm(k, shape, scale):
        return jax.random.normal(k, shape, f32) * scale

    return {
        'x': nrm(ks[0], (BATCH, SEQ, D_MODEL), 1.0),
        'meta_tokens': nrm(ks[1], (N_META, D_MODEL), 1.0),
        'w_in': nrm(ks[2], (DEPTH, D_MODEL, IN_W), D_MODEL ** -0.5),
        'q_norm_g': 1.0 + nrm(ks[3], (DEPTH, Q_LORA), 0.02),
        'w_uq': nrm(ks[4], (DEPTH, Q_LORA, MLA_HEADS * (QK_NOPE + QK_ROPE)), Q_LORA ** -0.5),
        'kv_norm_g': 1.0 + nrm(ks[5], (DEPTH, KV_LORA), 0.02),
        'w_ukv': nrm(ks[6], (DEPTH, KV_LORA, MLA_HEADS * (QK_NOPE + V_DIM)), KV_LORA ** -0.5),
        'mla_out_g': 1.0 + nrm(ks[7], (DEPTH, MLA_W), 0.02),
        'sb_out_g': 1.0 + nrm(ks[8], (DEPTH, SB_W), 0.02),
        'w_o': nrm(ks[9], (DEPTH, MIX_W, D_MODEL), DN_BETA * MIX_W ** -0.5),
        'ln1_g': 1.0 + nrm(ks[10], (DEPTH, D_MODEL), 0.02),
        'ln1_b': nrm(ks[11], (DEPTH, D_MODEL), 0.01),
        'w_router': nrm(ks[12], (DEPTH, D_MODEL, N_EXPERTS), D_MODEL ** -0.5),
        'b_router': nrm(ks[13], (DEPTH, N_EXPERTS), 0.01),
        'w_gate': nrm(ks[14], (DEPTH, N_EXPERTS, D_MODEL, D_FF), D_MODEL ** -0.5),
        'b_gate': nrm(ks[15], (DEPTH, N_EXPERTS, D_FF), 0.01),
        'w_up': nrm(ks[16], (DEPTH, N_EXPERTS, D_MODEL, D_FF), D_MODEL ** -0.5),
        'b_up': nrm(ks[17], (DEPTH, N_EXPERTS, D_FF), 0.01),
        'w_down': nrm(ks[18], (DEPTH, N_EXPERTS, D_FF, D_MODEL), DN_BETA * D_FF ** -0.5),
        'b_down': nrm(ks[19], (DEPTH, N_EXPERTS, D_MODEL), 0.01),
        'ln2_g': 1.0 + nrm(ks[20], (DEPTH, D_MODEL), 0.02),
        'ln2_b': nrm(ks[21], (DEPTH, D_MODEL), 0.01),
    }


def reference(x, meta_tokens, w_in, q_norm_g, w_uq, kv_norm_g, w_ukv, mla_out_g, sb_out_g, w_o,
              ln1_g, ln1_b, w_router, b_router, w_gate, b_gate, w_up, b_up, w_down, b_down,
              ln2_g, ln2_b):
    b = x.shape[0]
    meta = jnp.broadcast_to(meta_tokens[None].astype(x.dtype), (b, N_META, D_MODEL))
    h = jnp.concatenate([meta, x], axis=1)
    l = h.shape[1]
    cos, sin = rope_tables(l)
    for i in range(DEPTH):
        a = token_mixing(h, cos, sin, w_in[i], q_norm_g[i], w_uq[i], kv_norm_g[i], w_ukv[i],
                         mla_out_g[i], sb_out_g[i], w_o[i])
        h = layer_norm(DN_ALPHA * h + a, ln1_g[i], ln1_b[i])
        f = moe_ffn(h.reshape(b * l, D_MODEL), w_router[i], b_router[i], w_gate[i], b_gate[i],
                    w_up[i], b_up[i], w_down[i], b_down[i]).reshape(b, l, D_MODEL)
        h = layer_norm(DN_ALPHA * h + f, ln2_g[i], ln2_b[i])
    return h[:, N_META:]
```

```cpp
#include <hip/hip_runtime.h>
#include <cstdio>
#include <cstdint>
#include <cmath>

#define LAS __attribute__((address_space(3)))
#define GAS __attribute__((address_space(1)))
typedef unsigned short bf16_t;
typedef short bf16x8 __attribute__((ext_vector_type(8)));
typedef short s16x4 __attribute__((ext_vector_type(4)));
typedef float f32x4 __attribute__((ext_vector_type(4)));
typedef float f32x2 __attribute__((ext_vector_type(2)));
typedef float f32x16 __attribute__((ext_vector_type(16)));
typedef unsigned u32x4 __attribute__((ext_vector_type(4)));
typedef unsigned u32x2 __attribute__((ext_vector_type(2)));
typedef __bf16 bf16x2_t __attribute__((ext_vector_type(2)));

constexpr int NB = 8, SEQ = 8192, DM = 1024;
constexpr int MX = NB * SEQ;
constexpr int MT = MX + 256;
constexpr int NMETA = 16;
constexpr int NPOS = SEQ + NMETA;
constexpr int NE = 32, DFF = 1024;
constexpr int BINCAP = 65536;
constexpr float LOG2E = 1.4426950408889634f;
constexpr float DN_ALPHA = 1.189207115002721f;
constexpr float LN_EPS = 1e-5f, RMS_EPS = 1e-6f;
constexpr float QSCALE = 0.07216878364870322f * LOG2E;
constexpr float SBSCALE = 0.125f * LOG2E;

constexpr size_t MiB = 1u << 20;
constexpr size_t WS_CTL = 0, CTL_ZERO_BYTES = 1 * MiB;
constexpr size_t WS_ROPE = 1 * MiB;
constexpr size_t WS_WIN = 4 * MiB;
constexpr size_t WS_WUQ = 9 * MiB - MiB / 2;
constexpr size_t WS_WUKV = 9 * MiB;
constexpr size_t WS_WR = 10 * MiB - MiB / 2;
constexpr size_t WS_WO = 10 * MiB;
constexpr size_t WS_SSQQ = 12 * MiB;
constexpr size_t WS_SSQKV = 13 * MiB + MiB / 8;
constexpr size_t WS_SLOT = 14 * MiB + MiB / 2;
constexpr size_t WS_GATEV = 15 * MiB + MiB / 2;
constexpr size_t WS_TOKBIN = 17 * MiB;
constexpr size_t WS_WDN = 25 * MiB;
constexpr size_t WS_WGU = 57 * MiB;
constexpr size_t WS_HB = 121 * MiB;
constexpr size_t WS_H1Q = 250 * MiB;
constexpr size_t WS_R0 = 314 * MiB;
constexpr size_t R_CQ = WS_R0, R_CKV = WS_R0 + 33 * MiB, R_SBQ = WS_R0 + 66 * MiB, R_SBK = WS_R0 + 131 * MiB, R_SBV = WS_R0 + 196 * MiB;
constexpr size_t R_Q = WS_R0 + 261 * MiB, R_K = WS_R0 + 358 * MiB, R_V = WS_R0 + 455 * MiB, R_O = WS_R0 + 520 * MiB;
constexpr size_t R_SSQO = WS_R0 + 650 * MiB;
constexpr size_t R_LNST = WS_R0 + 656 * MiB;
constexpr size_t R_A2 = WS_R0, R_Y = WS_R0 + 8 * MiB;
constexpr size_t WS_END = 1024 * MiB;
constexpr int A_TILES0 = 1024, MAX_TILES = 1055;
constexpr float WGU_SCALE = 32.f, WDN_SCALE = 64.f;
static_assert(R_O + (size_t)MX * 1024 * 2 <= WS_END && R_CQ + (size_t)MT * 512 <= R_CKV && R_CKV + (size_t)MT * 512 <= R_SBQ && R_SBQ + (size_t)MT * 1024 <= R_SBK && R_SBV + (size_t)MT * 1024 <= R_Q && R_Q + (size_t)MX * 1536 <= R_K && R_K + (size_t)MT * 1536 <= R_V && R_V + (size_t)MT * 1024 <= R_O, "attention region");
static_assert(R_LNST >= R_SSQO + (size_t)MX * 64 && R_LNST + (size_t)MX * 128 <= WS_END, "ln stats");
static_assert(R_SSQO >= R_O + (size_t)MX * 2048 && R_SSQO + (size_t)MX * 64 <= WS_END && R_Y + (size_t)MAX_TILES * 262144 <= WS_END && R_A2 + (size_t)(MAX_TILES - A_TILES0) * 262144 <= R_Y, "moe region");
static_assert(WS_GATEV + (size_t)MX * 16 <= WS_TOKBIN && WS_SLOT + (size_t)MX * 16 <= WS_GATEV && WS_TOKBIN + (size_t)NE * BINCAP * 4 <= WS_WDN && WS_WDN + (size_t)NE * 1024 * 1024 <= WS_WGU && WS_WGU + (size_t)NE * 2048 * 1024 <= WS_HB && WS_ROPE + (size_t)NPOS * 32 * 8 <= WS_WIN && WS_WIN + (size_t)2304 * 2048 <= WS_WUQ && WS_WUQ + 768 * 512 <= WS_WUKV && WS_WUKV + 1024 * 512 <= WS_WR && WS_WR + 256 * 2048 <= WS_WO && WS_WO + 1024 * 2048 <= WS_SSQQ, "map2");
static_assert(R_SBK - R_SBQ == R_SBV - R_SBK && WS_HB + (size_t)MT * 2048 <= WS_H1Q && WS_H1Q + (size_t)MX * 1024 <= WS_R0 && WS_SSQQ + (size_t)MT * 16 <= WS_SSQKV && WS_SSQKV + (size_t)MT * 16 <= WS_SLOT, "map");
constexpr int CW_BAR = 4096;
constexpr int CW_CNT = 16384;
constexpr int CW_Q = 8192;

constexpr int RING_BYTES = 131072;
constexpr int MISC_OFF = RING_BYTES;
constexpr int AUX_OFF = MISC_OFF + 4096;
constexpr int RS_OFF = MISC_OFF + 8192;
constexpr int LDS_BYTES = 147456;

__device__ __forceinline__ unsigned cvtpk(float lo, float hi) { f32x2 v = {lo, hi}; bf16x2_t b = __builtin_convertvector(v, bf16x2_t); return __builtin_bit_cast(unsigned, b); }
__device__ __forceinline__ float bf_lo(unsigned w) { return __uint_as_float(w << 16); }
__device__ __forceinline__ float bf_hi(unsigned w) { return __uint_as_float(w & 0xffff0000u); }
__device__ __forceinline__ float wave_sum(float v) {
#pragma unroll
    for (int o = 1; o < 64; o <<= 1) v += __shfl_xor(v, o);
    return v;
}
__device__ __forceinline__ unsigned pk4_fp8(float a, float b, float c, float d) { int w = __builtin_amdgcn_cvt_pk_fp8_f32(a, b, 0, false); w = __builtin_amdgcn_cvt_pk_fp8_f32(c, d, w, true); return (unsigned)w; }
__device__ __forceinline__ f32x4 unpk4_fp8(unsigned w) { const f32x2 lo = __builtin_amdgcn_cvt_pk_f32_fp8((int)w, false), hi = __builtin_amdgcn_cvt_pk_f32_fp8((int)w, true); return (f32x4){lo[0], lo[1], hi[0], hi[1]}; }
__device__ __forceinline__ float ex2(float x) { return __builtin_amdgcn_exp2f(x); }
__device__ __forceinline__ float lg2(float x) { return __builtin_amdgcn_logf(x); }

namespace pg8 {
constexpr int BM = 256, BK = 64, HALF = 128, HTB = HALF * BK * 2, STAGE_BYTES = 8 * HTB, NXCD = 8, WGM = 8;
__host__ __device__ __forceinline__ int lds_byte(int r, int c) { const int st = (r >> 4) * 2 + (c >> 5), rr = r & 15, cc = c & 31, ob = rr * 64 + cc * 2; return st * 1024 + (ob ^ (((ob >> 9) & 1) << 5)); }
__host__ __device__ __forceinline__ void stage_rc(int b, int& R, int& C) { const int st = b / 1024, sb = b % 1024, swz = sb ^ (((sb >> 9) & 1) << 5); R = (st >> 1) * 16 + swz / 64; C = (st & 1) * 32 + (swz % 64) / 2; }
__host__ __device__ __forceinline__ int perm32(int rho) { const int n = rho >> 4, i = rho & 15; return 8 * (i >> 2) + 4 * n + (i & 3); }

struct Unit { int pm, pn, e, r0, slot; };

struct SchedDense {
    const char* A; const char* Bt; int lda, K; int nM, nN, nwg, G, c;
    __device__ void init(const void* A_, const void* Bt_, int lda_, int K_, int M, int N, int G_, int c_) { A = (const char*)A_; Bt = (const char*)Bt_; lda = lda_ * 2; K = K_ * 2; nM = M / BM; nN = N / BM; nwg = nM * nN; G = G_; c = c_; }
    __device__ __forceinline__ bool next(int i, Unit& u) const {
        const long L = (long)i * G + c; if (L >= nwg) return false;
        int wgid = (int)L; { const int q = nwg / NXCD, r = nwg % NXCD, xcd = wgid % NXCD, off = wgid / NXCD; wgid = (xcd < r ? xcd * (q + 1) : r * (q + 1) + (xcd - r) * q) + off; }
        const int nig = WGM * nN, gid = wgid / nig, fm = gid * WGM, gsz = (nM - fm) < WGM ? (nM - fm) : WGM;
        u.pm = fm + ((wgid % nig) % gsz); u.pn = (wgid % nig) / gsz; u.e = 0; u.r0 = 0; return true;
    }
    __device__ __forceinline__ int lda_() const { return lda; }
    __device__ __forceinline__ const char* a_base(const Unit& u) const { return A + (size_t)u.pm * BM * lda; }
    __device__ __forceinline__ const char* b_base(const Unit& u) const { return Bt + (size_t)u.pn * BM * K; }
    __device__ __forceinline__ void a_offs(const Unit&, unsigned (&vo)[2][2], const int (&R)[2], const int (&C)[2]) const {
#pragma unroll
        for (int h = 0; h < 2; ++h)
#pragma unroll
            for (int i = 0; i < 2; ++i) vo[h][i] = (unsigned)((h * HALF + R[i]) * lda + C[i] * 2);
    }
};

__device__ __forceinline__ void glds16(const char* sbase, unsigned voff, unsigned lds_dst) {
    unsigned keep;
    asm volatile("s_mov_b32 %0, m0\n\ts_mov_b32 m0, %3\n\ts_nop 2\n\tglobal_load_lds_dwordx4 %1, %2\n\ts_mov_b32 m0, %0" : "=&s"(keep) : "v"(voff), "s"(sbase), "s"(lds_dst) : "memory");
}
#define PG8_WAIT_V(n) asm volatile("s_waitcnt vmcnt(" #n ")" ::: "memory")
#define PG8_WAIT_L(n) asm volatile("s_waitcnt lgkmcnt(" #n ")" ::: "memory")
#define PG8_BAR __builtin_amdgcn_s_barrier()
#define PG8_SCHED __builtin_amdgcn_sched_barrier(0)

typedef int i32x8 __attribute__((ext_vector_type(8)));
typedef int i32x4 __attribute__((ext_vector_type(4)));
template <class Epi, class Sched, bool ALIGN_EPI, bool GATHER = false, bool F8 = false, bool ROWSCALE = false, int AUX = 0>
__device__ __forceinline__ void gemm_phase(LAS unsigned char* lds, const int K, const Sched& S, const Epi& E, int tid_) {
    asm volatile("" : "+v"(tid_));
    const int tid = tid_, wid = __builtin_amdgcn_readfirstlane(tid >> 6), lane = tid & 63, wr = wid >> 2, wc = wid & 3, fr = lane & 15, fq = lane >> 4;
    const int nt = K / (BK * 2);
    int sR[2], sC[2]; unsigned voffB[2], voffA[2];
#pragma unroll
    for (int i = 0; i < 2; ++i) { int R, C; stage_rc(tid * 16 + i * 8192, R, C); sR[i] = R; sC[i] = C; const int Rb = Epi::PERM ? ((R & ~31) + perm32(R & 31)) : R; voffB[i] = (unsigned)(Rb * K + C * 2); voffA[i] = (unsigned)(R * S.lda_() + C * 2); }
    const size_t kstep = (size_t)(BK * 2);
    const size_t hstepB = (size_t)HALF * K;
    const size_t hstepA = GATHER ? 0 : (size_t)HALF * S.lda_();
    const unsigned ldsw = (unsigned)wid * 1024u;
    const unsigned ldsd = (unsigned)__builtin_amdgcn_readfirstlane((int)((unsigned)(unsigned long)lds + ldsw));
    const int aoff = lds_byte(wr * 64 + fr, fq * 8), boff = lds_byte(wc * 32 + fr, fq * 8);
#define PG8_SA(b, h) (((b) * 2 + (h)) * HTB)
#define PG8_SB(b, h) ((4 + (b) * 2 + (h)) * HTB)
#define PG8_STAGE(bufoff, gbase, voff) do { _Pragma("unroll") for (int _i = 0; _i < 2; ++_i) \
        glds16((const char*)(gbase), (voff)[_i], ldsd + (unsigned)((bufoff) + _i * 8192)); } while (0)
#define PG8_STAGE_A(bufoff, gbase, h, vset) do { if constexpr (GATHER) { PG8_STAGE(bufoff, gbase, (vset)[h]); } else { PG8_STAGE(bufoff, (gbase) + (h) * hstepA, voffA); } } while (0)
#define PG8_LDA(dst, b, h) do { _Pragma("unroll") for (int m = 0; m < 4; ++m) _Pragma("unroll") for (int k = 0; k < 2; ++k) dst[m][k] = *(const LAS bf16x8*)(lds + PG8_SA(b, h) + aoff + m * 2048 + k * 1024); } while (0)
#define PG8_LDB(dst, b, h) do { _Pragma("unroll") for (int n = 0; n < 2; ++n) _Pragma("unroll") for (int k = 0; k < 2; ++k) dst[n][k] = *(const LAS bf16x8*)(lds + PG8_SB(b, h) + boff + n * 2048 + k * 1024); } while (0)
#define PG8_CAT(x) __builtin_shufflevector(__builtin_bit_cast(i32x4, (x)[0]), __builtin_bit_cast(i32x4, (x)[1]), 0, 1, 2, 3, 4, 5, 6, 7)
#define PG8_MMA(ai, bj, At, Bt) do { __builtin_amdgcn_s_setprio(1); _Pragma("unroll") for (int m = 0; m < 4; ++m) _Pragma("unroll") for (int n = 0; n < 2; ++n) { \
        if constexpr (F8) { acc[ai][bj][m][n] = __builtin_amdgcn_mfma_scale_f32_16x16x128_f8f6f4(PG8_CAT(Bt[n]), PG8_CAT(At[m]), acc[ai][bj][m][n], 0, 0, 0, 0, 0, 0); } \
        else { _Pragma("unroll") for (int k = 0; k < 2; ++k) acc[ai][bj][m][n] = __builtin_amdgcn_mfma_f32_16x16x32_bf16(Bt[n][k], At[m][k], acc[ai][bj][m][n], 0, 0, 0); } } __builtin_amdgcn_s_setprio(0); } while (0)
    Unit cur, nxt; int ui = 0;
    if (!S.next(0, cur)) return;
    f32x4 acc[2][2][4][2];
#pragma unroll
    for (int a = 0; a < 2; ++a)
#pragma unroll
        for (int b = 0; b < 2; ++b)
#pragma unroll
            for (int m = 0; m < 4; ++m)
#pragma unroll
                for (int n = 0; n < 2; ++n) acc[a][b][m][n] = (f32x4){0.f, 0.f, 0.f, 0.f};
    bf16x8 At[4][2], B0[2][2], B1[2][2];
    const char* cA = S.a_base(cur); const char* cB = S.b_base(cur);
    unsigned vc[2][2], vn[2];
    if constexpr (ROWSCALE) S.prep(cur, 0, tid);
    if constexpr (AUX == 1) { if (tid < 256) ((LAS float*)(lds + AUX_OFF))[tid] = *S.aux_src(cur, tid); }
    if constexpr (AUX == 4) { if (tid < 256) ((LAS float*)(lds + AUX_OFF))[tid] = S.aux_xform(*S.aux_src4(cur, tid)); }
    if constexpr (GATHER) { S.a_toks(cur, vn, sR); vc[0][0] = (vn[0] & 0xffffu) * 1024u + sC[0] * 2; vc[0][1] = (vn[0] >> 16) * 1024u + sC[1] * 2; vc[1][0] = (vn[1] & 0xffffu) * 1024u + sC[0] * 2; vc[1][1] = (vn[1] >> 16) * 1024u + sC[1] * 2; }
    PG8_STAGE(PG8_SB(0, 0), cB, voffB); PG8_STAGE(PG8_SB(0, 1), cB + hstepB, voffB); PG8_STAGE_A(PG8_SA(0, 0), cA, 0, vc); PG8_STAGE_A(PG8_SA(0, 1), cA, 1, vc);
    if (wr == 1) PG8_BAR;
    PG8_WAIT_V(2); PG8_BAR;
    PG8_STAGE(PG8_SB(1, 0), cB + kstep, voffB); PG8_STAGE_A(PG8_SA(1, 0), cA + kstep, 0, vc); PG8_STAGE(PG8_SB(1, 1), cB + hstepB + kstep, voffB);
    PG8_WAIT_V(6); PG8_BAR;
    for (;;) {
        const bool has_next = S.next(ui + 1, nxt);
        const char* nA = has_next ? S.a_base(nxt) : cA; const char* nB = has_next ? S.b_base(nxt) : cB;
        if constexpr (GATHER) { if (has_next) S.a_toks(nxt, vn, sR); }
        if constexpr (ROWSCALE) { if (has_next) S.prep(nxt, (ui + 1) % 3, tid); }
        float auxv = 0.f; f32x4 auxv4 = (f32x4){0.f, 0.f, 0.f, 0.f};
        if constexpr (AUX == 1) { if (has_next && tid < 256) { const float* ap_ = S.aux_src(nxt, tid); asm volatile("global_load_dword %0, %1, off" : "=&v"(auxv) : "v"(ap_) : "memory"); } }
        if constexpr (AUX == 4) { if (has_next && tid < 256) { const f32x4* ap_ = S.aux_src4(nxt, tid); asm volatile("global_load_dwordx4 %0, %1, off" : "=&v"(auxv4) : "v"(ap_) : "memory"); } }
#pragma unroll 1
        for (int t = 0; t < nt; t += 2) {
            const bool last = (t == nt - 2);
            if constexpr (ROWSCALE) { if (t == nt / 2) { const LAS f32x2* rsl = (const LAS f32x2*)(lds + RS_OFF) + (ui % 3) * 256 + wr * 64 + (lane & 15);
#pragma unroll
                for (int ai = 0; ai < 2; ++ai)
#pragma unroll
                    for (int m = 0; m < 4; ++m) { const float rt = rsl[ai * 128 + m * 16][0];
#pragma unroll
                        for (int bj = 0; bj < 2; ++bj)
#pragma unroll
                            for (int n = 0; n < 2; ++n) acc[ai][bj][m][n] *= rt; } } }
            const char* a1 = cA + (size_t)(t + 1) * kstep;
            const char* a2 = last ? nA : cA + (size_t)(t + 2) * kstep; const char* b2 = last ? nB : cB + (size_t)(t + 2) * kstep;
            const char* a3 = a2 + kstep; const char* b3 = b2 + kstep;
            PG8_LDB(B0, 0, 0); PG8_LDB(B1, 0, 1); PG8_SCHED; PG8_LDA(At, 0, 0); PG8_STAGE_A(PG8_SA(1, 1), a1, 1, vc);
            if constexpr (GATHER) { if (last && has_next) { vc[0][0] = (vn[0] & 0xffffu) * 1024u + sC[0] * 2; vc[0][1] = (vn[0] >> 16) * 1024u + sC[1] * 2; vc[1][0] = (vn[1] & 0xffffu) * 1024u + sC[0] * 2; vc[1][1] = (vn[1] >> 16) * 1024u + sC[1] * 2; } }
            PG8_WAIT_V(8); PG8_WAIT_L(0); PG8_BAR; PG8_MMA(0, 0, At, B0); PG8_MMA(0, 1, At, B1); PG8_BAR; PG8_SCHED;
            PG8_LDA(At, 0, 1); PG8_STAGE(PG8_SB(0, 0), b2, voffB); PG8_STAGE(PG8_SB(0, 1), b2 + hstepB, voffB); PG8_STAGE_A(PG8_SA(0, 0), a2, 0, vc);
            PG8_WAIT_V(8);
            if constexpr (AUX == 1) { if (t == 0 && has_next && tid < 256) { asm volatile("" : "+v"(auxv)); ((LAS float*)(lds + AUX_OFF))[((ui + 1) % 3) * 256 + tid] = auxv; } }
            if constexpr (AUX == 4) { if (t == 0 && has_next && tid < 256) { asm volatile("" : "+v"(auxv4)); ((LAS float*)(lds + AUX_OFF))[((ui + 1) % 3) * 256 + tid] = S.aux_xform(auxv4); } }
            PG8_WAIT_L(0); PG8_BAR; PG8_MMA(1, 0, At, B0); PG8_MMA(1, 1, At, B1); PG8_BAR; PG8_SCHED;
            PG8_LDB(B0, 1, 0); PG8_LDB(B1, 1, 1); PG8_SCHED; PG8_LDA(At, 1, 0); PG8_STAGE_A(PG8_SA(0, 1), a2, 1, vc);
            PG8_WAIT_V(8); PG8_WAIT_L(0); PG8_BAR; PG8_MMA(0, 0, At, B0); PG8_MMA(0, 1, At, B1); PG8_BAR; PG8_SCHED;
            PG8_LDA(At, 1, 1); PG8_STAGE(PG8_SB(1, 0), b3, voffB); PG8_STAGE(PG8_SB(1, 1), b3 + hstepB, voffB); PG8_STAGE_A(PG8_SA(1, 0), a3, 0, vc);
            PG8_WAIT_V(8); PG8_WAIT_L(0); PG8_BAR; PG8_MMA(1, 0, At, B0); PG8_MMA(1, 1, At, B1); PG8_BAR; PG8_SCHED;
        }
        if constexpr (ALIGN_EPI) { if (wr == 0) PG8_BAR; }
        if constexpr (!Epi::AFTER_DRAIN) { int l2 = lane; asm volatile("" : "+v"(l2)); cur.slot = ui % 3; if constexpr (ROWSCALE) cur.r0 = ui % 3; E(acc, cur, wr, wc, l2 & 15, l2 >> 4); }
        if (!has_next) break;
#pragma unroll
        for (int a = 0; a < 2; ++a)
#pragma unroll
            for (int b = 0; b < 2; ++b)
#pragma unroll
                for (int m = 0; m < 4; ++m)
#pragma unroll
                    for (int n = 0; n < 2; ++n) acc[a][b][m][n] = (f32x4){0.f, 0.f, 0.f, 0.f};
        cur = nxt; cA = nA; cB = nB; ++ui;
        if constexpr (ALIGN_EPI) { if (wr == 1) PG8_BAR; }
    }
    PG8_WAIT_V(0);
    if constexpr (!ALIGN_EPI) { if (wr == 0) PG8_BAR; }
    PG8_BAR;
    if constexpr (Epi::AFTER_DRAIN) { E.fused(acc, cur, wr, wc, fr, fq, lds, wid, lane); }
#undef PG8_SA
#undef PG8_SB
#undef PG8_STAGE
#undef PG8_STAGE_A
#undef PG8_LDA
#undef PG8_LDB
#undef PG8_MMA
#undef PG8_CAT
}
}

typedef f32x4 acc_t[2][2][4][2];

__device__ __forceinline__ u32x4 pack8(const f32x4 a, const f32x4 b, float s) {
    u32x4 w; w.x = cvtpk(a[0] * s, a[1] * s); w.y = cvtpk(a[2] * s, a[3] * s); w.z = cvtpk(b[0] * s, b[1] * s); w.w = cvtpk(b[2] * s, b[3] * s); return w;
}
__device__ __forceinline__ void rope8(f32x4& a, f32x4& b, const f32x4 cs0, const f32x4 cs1) {
    const float x0 = a[0], x1 = a[1], x2 = a[2], x3 = a[3], y0 = b[0], y1 = b[1], y2 = b[2], y3 = b[3];
    a[0] = x0 * cs0[0] - x1 * cs0[1]; a[1] = x1 * cs0[0] + x0 * cs0[1];
    a[2] = x2 * cs0[2] - x3 * cs0[3]; a[3] = x3 * cs0[2] + x2 * cs0[3];
    b[0] = y0 * cs1[0] - y1 * cs1[1]; b[1] = y1 * cs1[0] + y0 * cs1[1];
    b[2] = y2 * cs1[2] - y3 * cs1[3]; b[3] = y3 * cs1[2] + y2 * cs1[3];
}
__device__ __forceinline__ int row_pos(int row) { return row < MX ? NMETA + (row & (SEQ - 1)) : ((row - MX) < NPOS ? (row - MX) : NPOS - 1); }

struct EpiInProj {
    static constexpr bool PERM = true, AFTER_DRAIN = false;
    unsigned char* ws; const float* rope;
    __device__ __forceinline__ void operator()(const acc_t& acc, const pg8::Unit& u, int wr, int wc, int fr, int fq) const {
        const int pn = u.pn; const int rowb = u.pm * 256 + wr * 64 + fr;
        if (pn <= 1) {
            bf16_t* dst = (bf16_t*)(ws + R_CQ + (size_t)pn * (R_CKV - R_CQ)); float* ssq = (float*)(ws + WS_SSQQ + (size_t)pn * (WS_SSQKV - WS_SSQQ));
#pragma unroll
            for (int ai = 0; ai < 2; ++ai)
#pragma unroll
                for (int m = 0; m < 4; ++m) { const int row = rowb + ai * 128 + m * 16; float s = 0.f;
#pragma unroll
                    for (int bj = 0; bj < 2; ++bj) { const f32x4 v0 = acc[ai][bj][m][0], v1 = acc[ai][bj][m][1];
                        s += (v0[0] * v0[0] + v0[1] * v0[1]) + (v0[2] * v0[2] + v0[3] * v0[3]) + (v1[0] * v1[0] + v1[1] * v1[1]) + (v1[2] * v1[2] + v1[3] * v1[3]);
                        *(u32x4*)(dst + (size_t)row * 256 + bj * 128 + wc * 32 + 8 * fq) = pack8(v0, v1, 1.f); }
                    s += __shfl_xor(s, 16); s += __shfl_xor(s, 32);
                    if (fq == 0) ssq[(size_t)row * 4 + wc] = s; }
        } else if (pn <= 7) {
            const int t = pn - 2; bf16_t* dst = (bf16_t*)(ws + R_SBQ + (size_t)(t >> 1) * (R_SBK - R_SBQ)); const int colt = (t & 1) * 256; const float sc = t < 2 ? SBSCALE : 1.f;
#pragma unroll
            for (int ai = 0; ai < 2; ++ai)
#pragma unroll
                for (int m = 0; m < 4; ++m) { const int row = rowb + ai * 128 + m * 16;
#pragma unroll
                    for (int bj = 0; bj < 2; ++bj) *(u32x4*)(dst + (size_t)row * 512 + colt + bj * 128 + wc * 32 + 8 * fq) = pack8(acc[ai][bj][m][0], acc[ai][bj][m][1], sc); }
        } else {
            bf16_t* Kb = (bf16_t*)(ws + R_K);
            if (wc < 2) { const int c0 = 32 * wc + 8 * fq;
#pragma unroll
                for (int ai = 0; ai < 2; ++ai)
#pragma unroll
                    for (int m = 0; m < 4; ++m) { const int row = rowb + ai * 128 + m * 16; const int pos = row_pos(row);
                        const f32x4 cs0 = *(const f32x4*)(rope + ((size_t)pos * 32 + (c0 >> 1)) * 2), cs1 = *(const f32x4*)(rope + ((size_t)pos * 32 + (c0 >> 1) + 2) * 2);
                        f32x4 a = acc[ai][0][m][0], b = acc[ai][0][m][1]; rope8(a, b, cs0, cs1); const u32x4 w = pack8(a, b, 1.f);
#pragma unroll
                        for (int h = 0; h < 4; ++h) *(u32x4*)(Kb + (size_t)row * 768 + h * 192 + 128 + c0) = w; } }
        }
    }
};
struct EpiQ {
    static constexpr bool PERM = true, AFTER_DRAIN = false;
    bf16_t* Q;
    __device__ __forceinline__ void operator()(const acc_t& acc, const pg8::Unit& u, int wr, int wc, int fr, int fq) const {
        const int rowb = u.pm * 256 + wr * 64 + fr;
#pragma unroll
        for (int ai = 0; ai < 2; ++ai)
#pragma unroll
            for (int m = 0; m < 4; ++m) { bf16_t* rowp = Q + (size_t)(rowb + ai * 128 + m * 16) * 768 + u.pn * 256 + wc * 32 + 8 * fq;
#pragma unroll
                for (int bj = 0; bj < 2; ++bj) *(u32x4*)(rowp + bj * 128) = pack8(acc[ai][bj][m][0], acc[ai][bj][m][1], 1.f); }
    }
};
struct SchedKV : pg8::SchedDense {
    const float* ssq;
    __device__ __forceinline__ const f32x4* aux_src4(const pg8::Unit& u, int tid) const { return (const f32x4*)(ssq + (size_t)(u.pm * 256 + tid) * 4); }
    __device__ __forceinline__ float aux_xform(const f32x4 sq) const { return 1.f / sqrtf(((sq[0] + sq[1]) + (sq[2] + sq[3])) * (1.f / 256.f) + RMS_EPS); }
};
struct EpiKV {
    static constexpr bool PERM = true, AFTER_DRAIN = false;
    bf16_t *Kb, *Vb; LAS unsigned char* ldsb;
    __device__ __forceinline__ void operator()(const acc_t& acc, const pg8::Unit& u, int wr, int wc, int fr, int fq) const {
        const int rowb = u.pm * 256 + wr * 64 + fr; const LAS float* ax = (const LAS float*)(ldsb + AUX_OFF) + u.slot * 256 + wr * 64 + fr;
#pragma unroll
        for (int ai = 0; ai < 2; ++ai)
#pragma unroll
            for (int m = 0; m < 4; ++m) { const int row = rowb + ai * 128 + m * 16; const float rs = ax[ai * 128 + m * 16];
#pragma unroll
                for (int bj = 0; bj < 2; ++bj) { const int cc = (u.pn & 1) * 256 + bj * 128 + wc * 32 + 8 * fq;
                    bf16_t* p = u.pn < 2 ? Kb + (size_t)row * 768 + (u.pn * 2 + bj) * 192 + wc * 32 + 8 * fq : Vb + (size_t)row * 512 + cc;
                    *(u32x4*)p = pack8(acc[ai][bj][m][0], acc[ai][bj][m][1], rs); } }
    }
};
struct SchedWo : pg8::SchedDense {
    const float* ssqo; LAS unsigned char* ldsb;
    __device__ __forceinline__ void prep(const pg8::Unit& u, int slot, int tid) const {
        if (tid < 256) { const float* p = ssqo + (size_t)(u.pm * 256 + tid) * 16; const f32x4 a = *(const f32x4*)p, b = *(const f32x4*)(p + 4), c = *(const f32x4*)(p + 8);
            const float rm = 1.f / sqrtf(((a[0] + a[1]) + (a[2] + a[3])) * (1.f / 512.f) + RMS_EPS), rs = 1.f / sqrtf((((b[0] + b[1]) + (b[2] + b[3])) + ((c[0] + c[1]) + (c[2] + c[3]))) * (1.f / 512.f) + RMS_EPS);
            ((LAS f32x2*)(ldsb + RS_OFF))[slot * 256 + tid] = (f32x2){rm / rs, rs}; }
    }
};
struct EpiWo {
    static constexpr bool PERM = true, AFTER_DRAIN = false;
    bf16_t* A; LAS unsigned char* ldsb;
    __device__ __forceinline__ void operator()(const acc_t& acc, const pg8::Unit& u, int wr, int wc, int fr, int fq) const {
        const int rowb = u.pm * 256 + wr * 64 + fr; const int col0 = u.pn * 256 + wc * 32 + 8 * fq;
        const LAS f32x2* rsl = (const LAS f32x2*)(ldsb + RS_OFF) + u.r0 * 256 + wr * 64 + fr;
#pragma unroll
        for (int ai = 0; ai < 2; ++ai)
#pragma unroll
            for (int m = 0; m < 4; ++m) { bf16_t* rowp = A + (size_t)(rowb + ai * 128 + m * 16) * 1024 + col0; const float rs = rsl[ai * 128 + m * 16][1];
#pragma unroll
                for (int bj = 0; bj < 2; ++bj) *(u32x4*)(rowp + bj * 128) = pack8(acc[ai][bj][m][0], acc[ai][bj][m][1], rs); }
    }
};
struct SchedOne : pg8::SchedDense {
    int p;
    __device__ __forceinline__ bool next(int i, pg8::Unit& u) const { if (i >= 1) return false; u.pm = p; u.pn = 0; u.e = 0; u.r0 = 0; return true; }
};
struct EpiWoLN {
    static constexpr bool PERM = true, AFTER_DRAIN = false;
    bf16_t* S; const bf16_t* XB; float* LNST; LAS unsigned char* ldsb;
    __device__ __forceinline__ void operator()(const acc_t& acc, const pg8::Unit& u, int wr, int wc, int fr, int fq) const {
        const int rl = wr * 64 + fr; const int col0 = u.pn * 256 + wc * 32 + 8 * fq;
        const LAS f32x2* rsl = (const LAS f32x2*)(ldsb + RS_OFF) + u.r0 * 256 + rl;
        f32x2* st = (f32x2*)LNST + (size_t)(u.pm * 256 + rl) * 16 + u.pn * 4 + wc;
        const size_t off0 = (size_t)(u.pm * 256 + rl) * 1024 + col0;
#pragma unroll
        for (int ai = 0; ai < 2; ++ai) {
            u32x4 xw[4][2];
#pragma unroll
            for (int m = 0; m < 4; ++m)
#pragma unroll
                for (int bj = 0; bj < 2; ++bj) xw[m][bj] = *(const u32x4*)(XB + off0 + (size_t)(ai * 128 + m * 16) * 1024 + bj * 128);
#pragma unroll
            for (int m = 0; m < 4; ++m) { const int ro = ai * 128 + m * 16; const size_t off = off0 + (size_t)ro * 1024; const float rs = rsl[ro][1];
                float s1 = 0.f, s2 = 0.f;
#pragma unroll
                for (int bj = 0; bj < 2; ++bj) { const u32x4 x4 = xw[m][bj];
                    const f32x4 v0 = acc[ai][bj][m][0] * rs + (f32x4){bf_lo(x4.x), bf_hi(x4.x), bf_lo(x4.y), bf_hi(x4.y)} * DN_ALPHA, v1 = acc[ai][bj][m][1] * rs + (f32x4){bf_lo(x4.z), bf_hi(x4.z), bf_lo(x4.w), bf_hi(x4.w)} * DN_ALPHA;
                    s1 += ((v0[0] + v0[1]) + (v0[2] + v0[3])) + ((v1[0] + v1[1]) + (v1[2] + v1[3]));
                    s2 += ((v0[0] * v0[0] + v0[1] * v0[1]) + (v0[2] * v0[2] + v0[3] * v0[3])) + ((v1[0] * v1[0] + v1[1] * v1[1]) + (v1[2] * v1[2] + v1[3] * v1[3]));
                    *(u32x4*)(S + off + bj * 128) = pack8(v0, v1, 1.f); }
                s1 += __shfl_xor(s1, 16); s2 += __shfl_xor(s2, 16); s1 += __shfl_xor(s1, 32); s2 += __shfl_xor(s2, 32);
                if (fq == 0) st[(size_t)ro * 16] = (f32x2){s1, s2}; }
        }
    }
};
struct EpiRouter {
    static constexpr bool PERM = true, AFTER_DRAIN = true;
    const float* b_router; unsigned* gcnt; unsigned* tokbin; unsigned* slot; float* gatev;
    __device__ __forceinline__ void fused(acc_t& acc, const pg8::Unit& u, int wr, int wc, int fr, int fq, LAS unsigned char* lds, int wid, int lane) const {
        LAS unsigned* lcnt = (LAS unsigned*)lds;
        LAS unsigned* lbase = (LAS unsigned*)(lds + 256);
        const int tix = wid * 64 + lane;
        if (tix < 32) lcnt[tix] = 0u;
        asm volatile("s_waitcnt lgkmcnt(0)" ::: "memory"); __builtin_amdgcn_s_barrier(); asm volatile("" ::: "memory");
        int my_e[8]; unsigned my_rank[8]; float my_gate[8];
        if (wc == 0) {
            const f32x4 bb0 = *(const f32x4*)(b_router + 8 * fq), bb1 = *(const f32x4*)(b_router + 8 * fq + 4);
#pragma unroll
            for (int ai = 0; ai < 2; ++ai)
#pragma unroll
                for (int m = 0; m < 4; ++m) {
                    float v[8]; { const f32x4 a = acc[ai][0][m][0] + bb0, b = acc[ai][0][m][1] + bb1; v[0] = a[0]; v[1] = a[1]; v[2] = a[2]; v[3] = a[3]; v[4] = b[0]; v[5] = b[1]; v[6] = b[2]; v[7] = b[3]; }
                    float tv[4]; int ti[4];
#pragma unroll
                    for (int k = 0; k < 4; ++k) {
                        float bv = v[0]; int bi = 0;
#pragma unroll
                        for (int j = 1; j < 8; ++j) if (v[j] > bv) { bv = v[j]; bi = j; }
                        bi += 8 * fq;
#pragma unroll
                        for (int o = 16; o <= 32; o <<= 1) { const float ov = __shfl_xor(bv, o); const int oi = __shfl_xor(bi, o); if (ov > bv || (ov == bv && oi < bi)) { bv = ov; bi = oi; } }
                        tv[k] = bv; ti[k] = bi;
#pragma unroll
                        for (int j = 0; j < 8; ++j) if (bi == 8 * fq + j) v[j] = -INFINITY;
                    }
                    const float e1 = __expf(tv[1] - tv[0]), e2 = __expf(tv[2] - tv[0]), e3 = __expf(tv[3] - tv[0]); const float inv = 1.f / (1.f + e1 + e2 + e3);
                    const float gk = fq == 0 ? inv : (fq == 1 ? e1 * inv : (fq == 2 ? e2 * inv : e3 * inv));
                    const int ek = fq == 0 ? ti[0] : (fq == 1 ? ti[1] : (fq == 2 ? ti[2] : ti[3]));
                    my_e[ai * 4 + m] = ek; my_gate[ai * 4 + m] = gk; my_rank[ai * 4 + m] = __hip_atomic_fetch_add(lcnt + ek, 1u, __ATOMIC_RELAXED, __HIP_MEMORY_SCOPE_WORKGROUP);
                }
        }
        asm volatile("s_waitcnt lgkmcnt(0)" ::: "memory"); __builtin_amdgcn_s_barrier(); asm volatile("" ::: "memory");
        if (tix < 32) { const unsigned c = lcnt[tix]; lbase[tix] = __hip_atomic_fetch_add(gcnt + CW_CNT + 64 * tix, c, __ATOMIC_RELAXED, __HIP_MEMORY_SCOPE_AGENT); }
        asm volatile("s_waitcnt vmcnt(0) lgkmcnt(0)" ::: "memory"); __builtin_amdgcn_s_barrier(); asm volatile("" ::: "memory");
        if (wc == 0) {
#pragma unroll
            for (int ai = 0; ai < 2; ++ai)
#pragma unroll
                for (int m = 0; m < 4; ++m) { const int row = u.pm * 256 + ai * 128 + wr * 64 + m * 16 + fr; const int e = my_e[ai * 4 + m]; const unsigned pos = lbase[e] + my_rank[ai * 4 + m];
                    tokbin[(size_t)e * BINCAP + pos] = (unsigned)row; slot[(size_t)row * 4 + fq] = ((unsigned)e << 20) | pos; gatev[(size_t)row * 4 + fq] = my_gate[ai * 4 + m]; }
        }
    }
};

struct MoeTab { LAS int* cnt; LAS int* ts; LAS unsigned char* te; };
__device__ __forceinline__ unsigned char* a_tile_ptr(unsigned char* dout, unsigned char* ws, int tile) { return tile < A_TILES0 ? dout + (size_t)tile * 262144 : ws + R_A2 + (size_t)(tile - A_TILES0) * 262144; }
__device__ __forceinline__ unsigned char* y_tile_ptr(unsigned char* ws, int tile) { return ws + R_Y + (size_t)tile * 262144; }

struct SchedGU {
    const char* H; const char* W; const unsigned* tokbin; MoeTab T; int G, c, NT;
    __device__ __forceinline__ bool next(int i, pg8::Unit& u) const {
        int tile, pn;
        if (G == 256) { const int x = c & 7, j = c >> 3; tile = i * 32 + x * 4 + (j >> 3); pn = j & 7; } else { const long L = (long)i * G + c; tile = (int)(L >> 3); pn = (int)(L & 7); }
        if (tile >= NT) return false;
        const int e = __builtin_amdgcn_readfirstlane((int)T.te[tile]);
        u.pm = tile; u.pn = pn; u.e = e; u.r0 = (tile - T.ts[e]) * 256; return true;
    }
    __device__ __forceinline__ int lda_() const { return 1024; }
    __device__ __forceinline__ const char* a_base(const pg8::Unit&) const { return H; }
    __device__ __forceinline__ const char* b_base(const pg8::Unit& u) const { return W + ((size_t)u.e * 2048 + (size_t)u.pn * 256) * 1024; }
    const float *b_gate, *b_up;
    __device__ __forceinline__ const float* aux_src(const pg8::Unit& u, int tid) const { return (tid < 128 ? b_gate : b_up - 128) + u.e * DFF + u.pn * 128 + tid; }
    __device__ __forceinline__ void a_toks(const pg8::Unit& u, unsigned (&vt)[2], const int (&R)[2]) const {
        const int n = T.cnt[u.e];
#pragma unroll
        for (int h = 0; h < 2; ++h) { const int r0 = u.r0 + h * 128 + R[0], r1 = u.r0 + h * 128 + R[1];
            const unsigned t0 = r0 < n ? tokbin[(size_t)u.e * BINCAP + r0] : 0u, t1 = r1 < n ? tokbin[(size_t)u.e * BINCAP + r1] : 0u; vt[h] = t0 | (t1 << 16); }
    }
};
struct EpiGU {
    static constexpr bool PERM = true, AFTER_DRAIN = false;
    LAS unsigned char* ldsb; unsigned char* dout; unsigned char* ws;
    __device__ __forceinline__ void operator()(const acc_t& acc, const pg8::Unit& u, int wr, int wc, int fr, int fq) const {
        const int col = u.pn * 128 + wc * 32 + 8 * fq;
        const LAS float* ax = (const LAS float*)(ldsb + AUX_OFF) + u.slot * 256 + wc * 32 + 8 * fq;
        const f32x4 bg0 = *(const LAS f32x4*)(ax), bg1 = *(const LAS f32x4*)(ax + 4), bu0 = *(const LAS f32x4*)(ax + 128), bu1 = *(const LAS f32x4*)(ax + 132);
        unsigned char* base = a_tile_ptr(dout, ws, u.pm) + col;
#pragma unroll
        for (int ai = 0; ai < 2; ++ai)
#pragma unroll
            for (int m = 0; m < 4; ++m) { const int r = ai * 128 + wr * 64 + m * 16 + fr; float o[8];
#pragma unroll
                for (int n = 0; n < 2; ++n) { const f32x4 g4 = acc[ai][0][m][n] * (1.f / WGU_SCALE) + (n ? bg1 : bg0), u4 = acc[ai][1][m][n] * (1.f / WGU_SCALE) + (n ? bu1 : bu0);
#pragma unroll
                    for (int j = 0; j < 4; ++j) { const float g = fminf(g4[j], 7.f), uu = fminf(fmaxf(u4[j], -7.f), 7.f); const float sg = __builtin_amdgcn_rcpf(1.f + ex2(-1.702f * LOG2E * g)); o[n * 4 + j] = (uu + 1.f) * (g * sg); } }
                u32x2 w; w.x = pk4_fp8(o[0], o[1], o[2], o[3]); w.y = pk4_fp8(o[4], o[5], o[6], o[7]);
                *(u32x2*)(base + (size_t)r * 1024) = w; }
    }
};
struct SchedDN {
    unsigned char* dout; unsigned char* ws; const char* W; MoeTab T; int G, c, NT;
    __device__ __forceinline__ bool next(int i, pg8::Unit& u) const {
        int tile, pn;
        if (G == 256) { const int x = c & 7, j = c >> 3; tile = i * 64 + x * 8 + (j >> 2); pn = j & 3; } else { const long L = (long)i * G + c; tile = (int)(L >> 2); pn = (int)(L & 3); }
        if (tile >= NT) return false;
        const int e = __builtin_amdgcn_readfirstlane((int)T.te[tile]);
        u.pm = tile; u.pn = pn; u.e = e; u.r0 = 0; return true;
    }
    const float* b_down;
    __device__ __forceinline__ const float* aux_src(const pg8::Unit& u, int tid) const { return b_down + u.e * DM + u.pn * 256 + tid; }
    __device__ __forceinline__ int lda_() const { return 1024; }
    __device__ __forceinline__ const char* a_base(const pg8::Unit& u) const { return (const char*)a_tile_ptr(dout, ws, u.pm); }
    __device__ __forceinline__ const char* b_base(const pg8::Unit& u) const { return W + ((size_t)u.e * 1024 + (size_t)u.pn * 256) * 1024; }
    __device__ __forceinline__ void a_offs(const pg8::Unit&, unsigned (&vo)[2][2], const int (&R)[2], const int (&C)[2]) const {
#pragma unroll
        for (int h = 0; h < 2; ++h)
#pragma unroll
            for (int i = 0; i < 2; ++i) vo[h][i] = (unsigned)((h * 128 + R[i]) * 1024 + C[i] * 2);
    }
};
struct EpiDN {
    static constexpr bool PERM = true, AFTER_DRAIN = false;
    LAS unsigned char* ldsb; unsigned char* ws;
    __device__ __forceinline__ void operator()(const acc_t& acc, const pg8::Unit& u, int wr, int wc, int fr, int fq) const {
        unsigned char* base = y_tile_ptr(ws, u.pm);
#pragma unroll
        for (int bj = 0; bj < 2; ++bj) { const int col = u.pn * 256 + bj * 128 + wc * 32 + 8 * fq; const LAS float* ax = (const LAS float*)(ldsb + AUX_OFF) + u.slot * 256 + bj * 128 + wc * 32 + 8 * fq; const f32x4 b0 = *(const LAS f32x4*)(ax), b1 = *(const LAS f32x4*)(ax + 4);
#pragma unroll
            for (int ai = 0; ai < 2; ++ai)
#pragma unroll
                for (int m = 0; m < 4; ++m) { const int r = ai * 128 + wr * 64 + m * 16 + fr; const f32x4 v0 = acc[ai][bj][m][0] * (1.f / WDN_SCALE) + b0, v1 = acc[ai][bj][m][1] * (1.f / WDN_SCALE) + b1;
                    u32x2 w; w.x = pk4_fp8(v0[0], v0[1], v0[2], v0[3]); w.y = pk4_fp8(v1[0], v1[1], v1[2], v1[3]); *(u32x2*)(base + (size_t)r * 1024 + col) = w; } }
    }
};

namespace att {
__device__ __forceinline__ int crow(int r, int hh) { return (r & 3) + 8 * (r >> 2) + 4 * hh; }
__device__ __forceinline__ s16x4 vtr(const LAS unsigned char* p) { return __builtin_bit_cast(s16x4, __builtin_amdgcn_ds_read_tr16_b64_v4i16((LAS s16x4*)p)); }
#define MFMA32(a, b, c) __builtin_amdgcn_mfma_f32_32x32x16_bf16((a), (b), (c), 0, 0, 0)
constexpr float NEGB = -1.0e30f;

constexpr int MKB = 24576, MVB = 16384;
constexpr int M_KS = 0, M_VS = 3 * MKB, M_WSF = MISC_OFF + 2048;
constexpr float MLA_THR = 8.f;
__device__ __forceinline__ float max3f(float a, float b, float c) { return fmaxf(fmaxf(a, b), c); }
__device__ __forceinline__ void mla_qk(f32x16& p0, f32x16& p1, const LAS unsigned char* kb, const bf16x8 (&qf)[12]) {
#pragma unroll
    for (int d0 = 0; d0 < 12; ++d0) { const bf16x8 a0 = *(const LAS bf16x8*)(kb + d0 * 2048), a1 = *(const LAS bf16x8*)(kb + d0 * 2048 + 512); p0 = MFMA32(a0, qf[d0], p0); p1 = MFMA32(a1, qf[d0], p1); }
}
__device__ __forceinline__ void mla_mask(f32x16& p0, f32x16& p1, int t, int j, int qrel, int hh) {
    if (t == 0) {
#pragma unroll
        for (int r = 0; r < 16; ++r) { if (crow(r, hh) >= NMETA) p0[r] = NEGB; p1[r] = NEGB; }
    } else if (j >= 0) {
#pragma unroll
        for (int r = 0; r < 16; ++r) { const int kk = 64 * j + crow(r, hh); if (kk > qrel) p0[r] = NEGB; if (kk + 32 > qrel) p1[r] = NEGB; }
    }
}
__device__ __forceinline__ float mla_rowmax(const f32x16& p0, const f32x16& p1) {
    float a = max3f(p0[0], p0[1], p1[0]), c = max3f(p0[2], p0[3], p1[1]); a = max3f(a, p1[2], p1[3]);
#pragma unroll
    for (int r = 4; r < 16; r += 4) { a = max3f(a, p0[r], p0[r + 1]); c = max3f(c, p0[r + 2], p0[r + 3]); a = max3f(a, p1[r], p1[r + 1]); c = max3f(c, p1[r + 2], p1[r + 3]); }
    const float m = fmaxf(a, c);
    auto rr = __builtin_amdgcn_permlane32_swap(__float_as_uint(m), __float_as_uint(m), false, false);
    return fmaxf(__uint_as_float(rr[0]), __uint_as_float(rr[1]));
}
#define KLD(kb, d0, half) (*(const LAS bf16x8*)((kb) + (d0) * 2048 + (half) * 512))
#define VLD(vb, d0, ks, hi) vtr((vb) + (d0) * 4096 + (ks) * 1024 + (hi) * 512)
#define VPK(l, h) ((bf16x8){l[0], l[1], l[2], l[3], h[0], h[1], h[2], h[3]})
#define SBAR() __builtin_amdgcn_sched_barrier(0)
__device__ __forceinline__ void mla_step(f32x16 (&o)[4], float& l_run, float& mref, const bf16x8 (&qf)[12], const LAS unsigned char* kb, const LAS unsigned char* vb, LAS float* wsf,
                                         int r32, int hh, int t, int j, int qrel) {
    f32x16 c0, c1;
    bf16x8 ka0 = KLD(kb, 0, 0), kb0f = KLD(kb, 0, 1), ka1 = KLD(kb, 1, 0), kb1f = KLD(kb, 1, 1);
    s16x4 vl0, vh0, vl1, vh1, vl2, vh2, vl3, vh3;
    { const float nm_ = -mref; _Pragma("unroll") for (int r = 0; r < 16; ++r) { c0[r] = nm_; c1[r] = nm_; } }
    c0 = MFMA32(ka0, qf[0], c0); ka0 = KLD(kb, 2, 0); SBAR();
    c1 = MFMA32(kb0f, qf[0], c1); kb0f = KLD(kb, 2, 1); SBAR();
    c0 = MFMA32(ka1, qf[1], c0); ka1 = KLD(kb, 3, 0); SBAR();
    c1 = MFMA32(kb1f, qf[1], c1); kb1f = KLD(kb, 3, 1); SBAR();
    c0 = MFMA32(ka0, qf[2], c0); ka0 = KLD(kb, 4, 0); SBAR();
    c1 = MFMA32(kb0f, qf[2], c1); kb0f = KLD(kb, 4, 1); SBAR();
    c0 = MFMA32(ka1, qf[3], c0); ka1 = KLD(kb, 5, 0); SBAR();
    c1 = MFMA32(kb1f, qf[3], c1); kb1f = KLD(kb, 5, 1); SBAR();
    c0 = MFMA32(ka0, qf[4], c0); ka0 = KLD(kb, 6, 0); SBAR();
    c1 = MFMA32(kb0f, qf[4], c1); kb0f = KLD(kb, 6, 1); SBAR();
    c0 = MFMA32(ka1, qf[5], c0); ka1 = KLD(kb, 7, 0); SBAR();
    c1 = MFMA32(kb1f, qf[5], c1); kb1f = KLD(kb, 7, 1); SBAR();
    c0 = MFMA32(ka0, qf[6], c0); ka0 = KLD(kb, 8, 0); SBAR();
    c1 = MFMA32(kb0f, qf[6], c1); kb0f = KLD(kb, 8, 1); SBAR();
    c0 = MFMA32(ka1, qf[7], c0); ka1 = KLD(kb, 9, 0); SBAR();
    c1 = MFMA32(kb1f, qf[7], c1); kb1f = KLD(kb, 9, 1); SBAR();
    c0 = MFMA32(ka0, qf[8], c0); ka0 = KLD(kb, 10, 0); SBAR();
    c1 = MFMA32(kb0f, qf[8], c1); kb0f = KLD(kb, 10, 1); SBAR();
    c0 = MFMA32(ka1, qf[9], c0); ka1 = KLD(kb, 11, 0); SBAR();
    c1 = MFMA32(kb1f, qf[9], c1); kb1f = KLD(kb, 11, 1); SBAR();
    c0 = MFMA32(ka0, qf[10], c0); vl0 = VLD(vb, 0, 0, 0); vh0 = VLD(vb, 0, 0, 1); SBAR();
    c1 = MFMA32(kb0f, qf[10], c1); vl1 = VLD(vb, 1, 0, 0); vh1 = VLD(vb, 1, 0, 1); SBAR();
    c0 = MFMA32(ka1, qf[11], c0); vl2 = VLD(vb, 2, 0, 0); vh2 = VLD(vb, 2, 0, 1); SBAR();
    c1 = MFMA32(kb1f, qf[11], c1); vl3 = VLD(vb, 3, 0, 0); vh3 = VLD(vb, 3, 0, 1); SBAR();
    mla_mask(c0, c1, t, j, qrel, hh);
    const float mx = mla_rowmax(c0, c1);
    if (__builtin_expect(t == 0 || __any(mx > MLA_THR), 0)) {
        const float dl = (t == 0) ? mx : fmaxf(mx, 0.f); const float alpha = (t == 0) ? 1.f : ex2(-dl);
        mref += dl; l_run *= alpha;
#pragma unroll
        for (int r = 0; r < 16; ++r) { c0[r] -= dl; c1[r] -= dl; }
        if (hh == 0) wsf[r32] = alpha;
#pragma unroll
        for (int r = 0; r < 16; ++r) { const float a = wsf[crow(r, hh)];
#pragma unroll
            for (int d = 0; d < 4; ++d) o[d][r] *= a; }
    }
    SBAR();
    float rs = 0.f; u32x4 pw0, pw1, pw2, pw3;
    c0[0] = ex2(c0[0]);
    c0[1] = ex2(c0[1]);
    c0[2] = ex2(c0[2]);
    c0[3] = ex2(c0[3]);
    c0[4] = ex2(c0[4]);
    c0[5] = ex2(c0[5]);
    c0[6] = ex2(c0[6]);
    c0[7] = ex2(c0[7]);
    c0[8] = ex2(c0[8]);
    c0[9] = ex2(c0[9]);
    c0[10] = ex2(c0[10]);
    c0[11] = ex2(c0[11]);
    c0[12] = ex2(c0[12]);
    c0[13] = ex2(c0[13]);
    c0[14] = ex2(c0[14]);
    c0[15] = ex2(c0[15]);
    rs += c0[0];
    rs += c0[1];
    rs += c0[2];
    rs += c0[3];
    rs += c0[4];
    rs += c0[5];
    rs += c0[6];
    rs += c0[7];
    rs += c0[8];
    rs += c0[9];
    rs += c0[10];
    rs += c0[11];
    rs += c0[12];
    rs += c0[13];
    rs += c0[14];
    rs += c0[15];
    pw0[0] = cvtpk(c0[0], c0[1]);
    pw0[1] = cvtpk(c0[2], c0[3]);
    pw0[2] = cvtpk(c0[4], c0[5]);
    pw0[3] = cvtpk(c0[6], c0[7]);
    pw1[0] = cvtpk(c0[8], c0[9]);
    pw1[1] = cvtpk(c0[10], c0[11]);
    pw1[2] = cvtpk(c0[12], c0[13]);
    pw1[3] = cvtpk(c0[14], c0[15]);
    SBAR();
    o[0] = MFMA32(__builtin_bit_cast(bf16x8, pw0), VPK(vl0, vh0), o[0]); vl0 = VLD(vb, 0, 1, 0); vh0 = VLD(vb, 0, 1, 1); c1[0] = ex2(c1[0]); c1[1] = ex2(c1[1]); SBAR();
    o[1] = MFMA32(__builtin_bit_cast(bf16x8, pw0), VPK(vl1, vh1), o[1]); vl1 = VLD(vb, 1, 1, 0); vh1 = VLD(vb, 1, 1, 1); c1[2] = ex2(c1[2]); c1[3] = ex2(c1[3]); rs += c1[0] + c1[1]; SBAR();
    o[2] = MFMA32(__builtin_bit_cast(bf16x8, pw0), VPK(vl2, vh2), o[2]); vl2 = VLD(vb, 2, 1, 0); vh2 = VLD(vb, 2, 1, 1); c1[4] = ex2(c1[4]); c1[5] = ex2(c1[5]); rs += c1[2] + c1[3]; SBAR();
    o[3] = MFMA32(__builtin_bit_cast(bf16x8, pw0), VPK(vl3, vh3), o[3]); vl3 = VLD(vb, 3, 1, 0); vh3 = VLD(vb, 3, 1, 1); c1[6] = ex2(c1[6]); c1[7] = ex2(c1[7]); rs += c1[4] + c1[5]; SBAR();
    o[0] = MFMA32(__builtin_bit_cast(bf16x8, pw1), VPK(vl0, vh0), o[0]); vl0 = VLD(vb, 0, 2, 0); vh0 = VLD(vb, 0, 2, 1); c1[8] = ex2(c1[8]); c1[9] = ex2(c1[9]); rs += c1[6] + c1[7]; pw2[0] = cvtpk(c1[0], c1[1]); pw2[1] = cvtpk(c1[2], c1[3]); SBAR();
    o[1] = MFMA32(__builtin_bit_cast(bf16x8, pw1), VPK(vl1, vh1), o[1]); vl1 = VLD(vb, 1, 2, 0); vh1 = VLD(vb, 1, 2, 1); c1[10] = ex2(c1[10]); c1[11] = ex2(c1[11]); rs += c1[8] + c1[9]; pw2[2] = cvtpk(c1[4], c1[5]); pw2[3] = cvtpk(c1[6], c1[7]); SBAR();
    o[2] = MFMA32(__builtin_bit_cast(bf16x8, pw1), VPK(vl2, vh2), o[2]); vl2 = VLD(vb, 2, 2, 0); vh2 = VLD(vb, 2, 2, 1); c1[12] = ex2(c1[12]); c1[13] = ex2(c1[13]); rs += c1[10] + c1[11]; SBAR();
    o[3] = MFMA32(__builtin_bit_cast(bf16x8, pw1), VPK(vl3, vh3), o[3]); vl3 = VLD(vb, 3, 2, 0); vh3 = VLD(vb, 3, 2, 1); c1[14] = ex2(c1[14]); c1[15] = ex2(c1[15]); rs += c1[12] + c1[13]; SBAR();
    o[0] = MFMA32(__builtin_bit_cast(bf16x8, pw2), VPK(vl0, vh0), o[0]); vl0 = VLD(vb, 0, 3, 0); vh0 = VLD(vb, 0, 3, 1); rs += c1[14] + c1[15]; pw3[0] = cvtpk(c1[8], c1[9]); pw3[1] = cvtpk(c1[10], c1[11]); SBAR();
    o[1] = MFMA32(__builtin_bit_cast(bf16x8, pw2), VPK(vl1, vh1), o[1]); vl1 = VLD(vb, 1, 3, 0); vh1 = VLD(vb, 1, 3, 1); pw3[2] = cvtpk(c1[12], c1[13]); pw3[3] = cvtpk(c1[14], c1[15]); SBAR();
    o[2] = MFMA32(__builtin_bit_cast(bf16x8, pw2), VPK(vl2, vh2), o[2]); vl2 = VLD(vb, 2, 3, 0); vh2 = VLD(vb, 2, 3, 1); SBAR();
    o[3] = MFMA32(__builtin_bit_cast(bf16x8, pw2), VPK(vl3, vh3), o[3]); vl3 = VLD(vb, 3, 3, 0); vh3 = VLD(vb, 3, 3, 1); SBAR();
    o[0] = MFMA32(__builtin_bit_cast(bf16x8, pw3), VPK(vl0, vh0), o[0]); SBAR();
    o[1] = MFMA32(__builtin_bit_cast(bf16x8, pw3), VPK(vl1, vh1), o[1]); SBAR();
    o[2] = MFMA32(__builtin_bit_cast(bf16x8, pw3), VPK(vl2, vh2), o[2]); SBAR();
    o[3] = MFMA32(__builtin_bit_cast(bf16x8, pw3), VPK(vl3, vh3), o[3]); SBAR();
    l_run += rs;
}
__device__ __forceinline__ void mla_unit(int b, int h, int qb, const bf16_t* __restrict__ Q, const bf16_t* __restrict__ K, const bf16_t* __restrict__ V, bf16_t* __restrict__ O, float* __restrict__ SSQO, const float* __restrict__ SSQQ, const float* __restrict__ ROPE, LAS unsigned char* lds, int tid_) {
    asm volatile("" : "+v"(tid_));
    const int tid = tid_, lane = tid & 63, r32 = lane & 31, hh = lane >> 5; const int wid = __builtin_amdgcn_readfirstlane(tid >> 6);
    const int NT = 4 * qb + 5;
    LAS float* wsf = (LAS float*)(lds + M_WSF) + wid * 64;
    const unsigned lds0 = (unsigned)__builtin_amdgcn_readfirstlane((int)(unsigned)(unsigned long)lds);
    const unsigned voffK = (unsigned)lane * 1536u, voffV = (unsigned)(lane >> 2) * 1024u + (unsigned)(lane & 3) * 16u;
    const char* Kh = (const char*)K + h * 384 + wid * 16; const char* Vh = (const char*)V + h * 256 + (wid >> 2) * 64 + (size_t)(wid & 3) * 16 * 1024;
#define MLA_ROW0(t) ((t) == 0 ? (size_t)MX : (size_t)(b * SEQ + ((t) - 1) * 64))
#define MLA_DMA_K(t, slot) do { const char* kp = Kh + MLA_ROW0(t) * 1536; const unsigned kd = lds0 + M_KS + (slot) * MKB + wid * 1024; \
        pg8::glds16(kp, voffK, kd); pg8::glds16(kp + 128, voffK, kd + 8192); pg8::glds16(kp + 256, voffK, kd + 16384); } while (0)
#define MLA_DMA_V(t, slot) do { const char* vp = Vh + MLA_ROW0(t) * 1024; const unsigned vd = lds0 + M_VS + (slot) * MVB + wid * 1024; \
        pg8::glds16(vp, voffV, vd); pg8::glds16(vp + 128, voffV, vd + 8192); } while (0)
    MLA_DMA_K(0, 0); MLA_DMA_V(0, 0); MLA_DMA_K(1, 1); MLA_DMA_V(1, 1);
    bf16x8 qf[12];
    { const int xrow = qb * 256 + wid * 32 + r32; const size_t grow = (size_t)b * SEQ + xrow;
      const bf16_t* qrow = Q + grow * 768 + h * 192 + hh * 8;
#pragma unroll
      for (int d0 = 0; d0 < 12; ++d0) qf[d0] = *(const bf16x8*)(qrow + d0 * 16);
      const f32x4 sq = *(const f32x4*)(SSQQ + grow * 4); const float rsq = QSCALE / sqrtf(((sq[0] + sq[1]) + (sq[2] + sq[3])) * (1.f / 256.f) + RMS_EPS);
      const float* rp = ROPE + ((size_t)(NMETA + xrow) * 32 + hh * 4) * 2;
#pragma unroll
      for (int d0 = 0; d0 < 12; ++d0) { const u32x4 w = __builtin_bit_cast(u32x4, qf[d0]);
          f32x4 a = (f32x4){bf_lo(w[0]), bf_hi(w[0]), bf_lo(w[1]), bf_hi(w[1])}, c = (f32x4){bf_lo(w[2]), bf_hi(w[2]), bf_lo(w[3]), bf_hi(w[3])};
          if (d0 >= 8) { const f32x4 cs0 = *(const f32x4*)(rp + (d0 - 8) * 16), cs1 = *(const f32x4*)(rp + (d0 - 8) * 16 + 4); rope8(a, c, cs0, cs1); }
          qf[d0] = __builtin_bit_cast(bf16x8, pack8(a, c, rsq)); }
#pragma unroll
      for (int d0 = 0; d0 < 12; ++d0) asm volatile("" : "+v"(qf[d0])); }
    f32x16 o[4];
#pragma unroll
    for (int d = 0; d < 4; ++d)
#pragma unroll
        for (int r = 0; r < 16; ++r) o[d][r] = 0.f;
    float mref = 0.f, l_run = 0.f;
    const int qrel = wid * 32 + r32;
    const int vboff = ((lane >> 4) & 1) * 32 + (lane & 3) * 8 + (4 * hh + ((lane & 15) >> 2)) * 64;
    const LAS unsigned char* kb0 = lds + M_KS + hh * 1024 + r32 * 16;
    asm volatile("s_waitcnt vmcnt(0)" ::: "memory"); __syncthreads();
    int sc = 0, sn = 2;
#pragma unroll 1
    for (int t = 0; t < NT; ++t) {
        const bool more = t + 2 < NT;
        if (more) { MLA_DMA_K(t + 2, sn); MLA_DMA_V(t + 2, sn); }
        const int j = t - (NT - 4);
        if (j <= (wid >> 1)) mla_step(o, l_run, mref, qf, kb0 + sc * MKB, lds + M_VS + sc * MVB + vboff, wsf, r32, hh, t, j, qrel);
        if (more) asm volatile("s_waitcnt vmcnt(5)" ::: "memory"); else asm volatile("s_waitcnt vmcnt(0)" ::: "memory");
        __syncthreads();
        sn = sc; sc = (sc == 2) ? 0 : sc + 1;
    }
    { float lt = l_run + __shfl_xor(l_run, 32); const float inv = 1.f / lt;
      if (hh == 0) wsf[32 + r32] = inv;
      bf16_t* orow = O + (size_t)(b * SEQ + qb * 256 + wid * 32) * 1024 + h * 128 + r32;
#pragma unroll
      for (int r = 0; r < 16; ++r) { const int q = crow(r, hh); const float a = wsf[32 + q]; float sq = 0.f;
#pragma unroll
          for (int d = 0; d < 4; ++d) { const float v = o[d][r] * a; sq += v * v; orow[(size_t)q * 1024 + d * 32] = (bf16_t)(cvtpk(v, 0.f) & 0xffffu); }
#pragma unroll
          for (int x = 1; x < 32; x <<= 1) sq += __shfl_xor(sq, x);
          if (r32 == 0) SSQO[(size_t)(b * SEQ + qb * 256 + wid * 32 + q) * 16 + h] = sq; } }
    asm volatile("s_waitcnt vmcnt(0)" ::: "memory"); __syncthreads();
#undef MLA_ROW0
#undef MLA_DMA_K
#undef MLA_DMA_V
}
#undef KLD
#undef VLD
#undef VPK
#undef SBAR

constexpr int SKB = 8192, SVB = 8192, SBUF = SKB + SVB;
constexpr int S_FLAG = 2 * SBUF;
constexpr float SB_STOP = 1.0e-43f;
template <bool MASKED>
__device__ __forceinline__ void sb_half(f32x16& P, int H, int t, int j, int qrel, int hh, float& carry) {
    float kp[16];
#pragma unroll
    for (int r = 0; r < 16; ++r) { const float E = ex2(fminf(P[r], 80.f)); const float k = __builtin_amdgcn_rcpf(1.f + E); float bt = E * k; float kk = k;
        if (MASKED) { const int key = 32 * H + crow(r, hh); const bool valid = (t == 0) ? (key < NMETA) : ((64 * j + key) < qrel); bt = valid ? bt : 0.f; kk = valid ? k : 1.f; }
        P[r] = bt; kp[r] = kk; }
    float e[16], a[4], bs[4];
#pragma unroll
    for (int g = 0; g < 4; ++g) { e[4 * g + 3] = 1.f; e[4 * g + 2] = kp[4 * g + 3]; e[4 * g + 1] = e[4 * g + 2] * kp[4 * g + 2]; e[4 * g] = e[4 * g + 1] * kp[4 * g + 1]; a[g] = e[4 * g] * kp[4 * g]; bs[g] = __shfl_xor(a[g], 32); }
    const float a3 = a[3], a23 = a[2] * a3, a123 = a[1] * a23, a0123 = a[0] * a123;
    const float b3 = bs[3], b23 = bs[2] * b3, b123 = bs[1] * b23, b0123 = bs[0] * b123;
    float SG[4];
    SG[3] = hh ? 1.f : b3; SG[2] = a3 * (hh ? b3 : b23); SG[1] = a23 * (hh ? b23 : b123); SG[0] = a123 * (hh ? b123 : b0123);
#pragma unroll
    for (int g = 0; g < 4; ++g) { const float cg = carry * SG[g];
#pragma unroll
        for (int i = 0; i < 4; ++i) P[4 * g + i] = P[4 * g + i] * (cg * e[4 * g + i]); }
    carry *= (a0123 * b0123);
}
__device__ __forceinline__ void sb_unit(int b, int h, int qb, const bf16_t* __restrict__ Q, const bf16_t* __restrict__ K, const bf16_t* __restrict__ V, bf16_t* __restrict__ O, float* __restrict__ SSQO, LAS unsigned char* lds, int tid_) {
    asm volatile("" : "+v"(tid_));
    const int tid = tid_, lane = tid & 63, r32 = lane & 31, hh = lane >> 5; const int wid = __builtin_amdgcn_readfirstlane(tid >> 6);
    const int NT = 4 * qb + 5;
    bf16x8 qf[4];
    { const bf16_t* qrow = Q + (size_t)(b * SEQ + qb * 256 + wid * 32 + r32) * 512 + h * 64 + hh * 8;
#pragma unroll
      for (int d0 = 0; d0 < 4; ++d0) qf[d0] = *(const bf16x8*)(qrow + d0 * 16); }
    LAS unsigned* flags = (LAS unsigned*)(lds + S_FLAG);
    u32x4 kreg, vreg;
    const int vkey = ((tid >> 6) & 3) * 16 + ((tid >> 2) & 15), vd = (tid >> 8) * 32 + (tid & 3) * 8;
#define SB_ROW(t, key) ((t) == 0 ? (size_t)(MX + (key)) : (size_t)(b * SEQ + ((t) - 1) * 64 + (key)))
#define SB_LOAD(t) do { kreg = *(const u32x4*)(K + SB_ROW(t, lane) * 512 + h * 64 + wid * 8); vreg = *(const u32x4*)(V + SB_ROW(t, vkey) * 512 + h * 64 + vd); } while (0)
#define SB_STORE(buf) do { LAS unsigned char* bb = lds + (buf) * SBUF; *(LAS u32x4*)(bb + wid * 1024 + lane * 16) = kreg; *(LAS u32x4*)(bb + SKB + tid * 16) = vreg; } while (0)
    SB_LOAD(NT - 1); SB_STORE(0); __syncthreads();
    f32x16 o[2];
#pragma unroll
    for (int d = 0; d < 2; ++d)
#pragma unroll
        for (int r = 0; r < 16; ++r) o[d][r] = 0.f;
    float carry = 1.f; bool wdone = false;
    const int qrel = wid * 32 + r32;
    const int vboff = ((lane >> 4) & 1) * 32 + (lane & 3) * 8 + (4 * hh + ((lane & 15) >> 2)) * 64;
    int it = 0;
    for (int t = NT - 1; t >= 0; --t, ++it) {
        const int buf = it & 1;
        if (t > 0) SB_LOAD(t - 1);
        const int j = t - (NT - 4);
        if (!wdone && j <= (wid >> 1)) {
            const LAS unsigned char* kb = lds + buf * SBUF + hh * 1024 + r32 * 16;
            f32x16 p0, p1;
#pragma unroll
            for (int r = 0; r < 16; ++r) { p0[r] = 0.f; p1[r] = 0.f; }
#pragma unroll
            for (int d0 = 0; d0 < 4; ++d0) { const bf16x8 a0 = *(const LAS bf16x8*)(kb + d0 * 2048), a1 = *(const LAS bf16x8*)(kb + d0 * 2048 + 512); p0 = MFMA32(a0, qf[d0], p0); p1 = MFMA32(a1, qf[d0], p1); }
            if (t == 0 || j >= 0) { sb_half<true>(p1, 1, t, j, qrel, hh, carry); sb_half<true>(p0, 0, t, j, qrel, hh, carry); }
            else { sb_half<false>(p1, 1, t, j, qrel, hh, carry); sb_half<false>(p0, 0, t, j, qrel, hh, carry); }
            u32x4 pw[4];
#pragma unroll
            for (int i = 0; i < 4; ++i) { pw[0][i] = cvtpk(p0[2 * i], p0[2 * i + 1]); pw[1][i] = cvtpk(p0[8 + 2 * i], p0[8 + 2 * i + 1]); pw[2][i] = cvtpk(p1[2 * i], p1[2 * i + 1]); pw[3][i] = cvtpk(p1[8 + 2 * i], p1[8 + 2 * i + 1]); }
            const LAS unsigned char* vb = lds + buf * SBUF + SKB + vboff;
#pragma unroll
            for (int d0 = 0; d0 < 2; ++d0)
#pragma unroll
                for (int ks = 0; ks < 4; ++ks) { const s16x4 lo = vtr(vb + d0 * 4096 + ks * 1024), hi = vtr(vb + d0 * 4096 + ks * 1024 + 512);
                    const bf16x8 vf = (bf16x8){lo[0], lo[1], lo[2], lo[3], hi[0], hi[1], hi[2], hi[3]};
                    o[d0] = MFMA32(__builtin_bit_cast(bf16x8, pw[ks]), vf, o[d0]); }
            wdone = __all(carry < SB_STOP);
        }
        if (lane == 0) flags[(it & 1) * 8 + wid] = wdone ? 1u : 0u;
        if (t > 0) SB_STORE(buf ^ 1);
        __syncthreads();
        unsigned alld = 1u;
#pragma unroll
        for (int w = 0; w < 8; ++w) alld &= flags[(it & 1) * 8 + w];
        if (alld) break;
    }
    { bf16_t* orow = O + (size_t)(b * SEQ + qb * 256 + wid * 32) * 1024 + 512 + h * 64 + r32;
#pragma unroll
      for (int r = 0; r < 16; ++r) { const int q = crow(r, hh); float sq = 0.f;
#pragma unroll
          for (int d = 0; d < 2; ++d) { const float v = o[d][r]; sq += v * v; orow[(size_t)q * 1024 + d * 32] = (bf16_t)(cvtpk(v, 0.f) & 0xffffu); }
#pragma unroll
          for (int x = 1; x < 32; x <<= 1) sq += __shfl_xor(sq, x);
          if (r32 == 0) SSQO[(size_t)(b * SEQ + qb * 256 + wid * 32 + q) * 16 + 4 + h] = sq; } }
    __syncthreads();
#undef SB_ROW
#undef SB_LOAD
#undef SB_STORE
}
}

#define XB_TMO      128
#define XB_XCNT(j)  (256  + 64 * (j))
#define XB_XSUB(j)  (1280 + 64 * (j))
#define XB_XGEN(j)  (2304 + 64 * (j))
#define XB_TOP      3328
#define XB_TOPGEN   3392
#define XCD_BAR_WORDS 3456
#define XB_SPIN_CAP (1u << 18)
__device__ __forceinline__ unsigned xb_ld(unsigned* p)              { return __hip_atomic_load(p, __ATOMIC_RELAXED, __HIP_MEMORY_SCOPE_AGENT); }
__device__ __forceinline__ unsigned xb_add(unsigned* p, unsigned v) { return __hip_atomic_fetch_add(p, v, __ATOMIC_RELAXED, __HIP_MEMORY_SCOPE_AGENT); }
__device__ __forceinline__ unsigned xb_xcc_id() { return (unsigned)__builtin_amdgcn_s_getreg((3 << 11) | 20) & 0xFu; }
#define XB_SPIN(cond, bar) do { unsigned _sp = 0; while (cond) { __builtin_amdgcn_s_sleep(1); \
    if ((++_sp & 255u) == 0u) { if (xb_ld(&(bar)[XB_TMO])) break; if (_sp > XB_SPIN_CAP) { atomicAdd(&(bar)[XB_TMO], 1u); break; } } } } while (0)
struct XcdBarrier { unsigned* bar; unsigned x; volatile LAS unsigned* st; };
__device__ __forceinline__ XcdBarrier xcd_barrier_post(unsigned* bar, volatile LAS unsigned* st, bool leader) {
    XcdBarrier b; b.bar = bar; b.x = xb_xcc_id(); b.st = st;
    if (leader) (void)xb_add(&bar[XB_XCNT(b.x)], 1u);
    return b;
}
__device__ __forceinline__ void xcd_barrier_complete(unsigned* bar, unsigned x, unsigned& nloc, unsigned& nx) {
    const unsigned G = gridDim.x * gridDim.y * gridDim.z;
    unsigned sum, cnt, mine, sp = 0u;
    for (;;) {
        sum = 0u; cnt = 0u; mine = 0u;
#pragma unroll
        for (unsigned j = 0; j < 16; ++j) { const unsigned c = xb_ld(&bar[XB_XCNT(j)]); sum += c; cnt += (c > 0u) ? 1u : 0u; mine = (j == x) ? c : mine; }
        if (sum == G) break;
        __builtin_amdgcn_s_sleep(1);
        if ((++sp & 255u) == 0u) { if (xb_ld(&bar[XB_TMO])) break; if (sp > XB_SPIN_CAP) { atomicAdd(&bar[XB_TMO], 1u); break; } }
    }
    nloc = mine > 0u ? mine : 1u; nx = cnt > 0u ? cnt : 1u;
}
__device__ __forceinline__ void xcd_barrier(const XcdBarrier& b, bool leader) {
    asm volatile("s_waitcnt vmcnt(0)" ::: "memory");
    __syncthreads();
    if (leader) {
        unsigned* bar = b.bar;
        __builtin_amdgcn_s_waitcnt(0);
        unsigned nloc = b.st[0], nx = b.st[1];
        if (nloc == 0u) { xcd_barrier_complete(bar, b.x, nloc, nx); b.st[0] = nloc; b.st[1] = nx; }
        const unsigned old = xb_add(&bar[XB_XSUB(b.x)], 1u);
        const unsigned gen = old / nloc;
        if (old + 1u == (gen + 1u) * nloc) {
            __builtin_amdgcn_fence(__ATOMIC_RELEASE, "agent");
            asm volatile("s_waitcnt vmcnt(0)" ::: "memory");
            const unsigned og = xb_add(&bar[XB_TOP], 1u);
            const unsigned tg = og / nx;
            if (og + 1u == (tg + 1u) * nx) xb_add(&bar[XB_TOPGEN], 1u);
            else XB_SPIN(xb_ld(&bar[XB_TOPGEN]) == tg, bar);
            __builtin_amdgcn_fence(__ATOMIC_ACQUIRE, "agent");
            xb_add(&bar[XB_XGEN(b.x)], 1u);
            asm volatile("s_waitcnt vmcnt(0)" ::: "memory");
        } else {
            XB_SPIN(xb_ld(&bar[XB_XGEN(b.x)]) == gen, bar);
            __builtin_amdgcn_fence(__ATOMIC_ACQUIRE, "agent");
            asm volatile("s_waitcnt vmcnt(0)" ::: "memory");
        }
    }
    __syncthreads();
}

template <class ColMap>
__device__ __forceinline__ void transpose_item(const float* __restrict__ W, int K, int Nsrc, bf16_t* __restrict__ WT, LAS float* scr, int kb, int n0, int lane, const float* __restrict__ kscale, ColMap cm) {
    const int k0 = 64 * kb; const int sc = cm(n0 + (lane & 31));
#pragma unroll 8
    for (int i = 0; i < 32; ++i) { const int kk = 2 * i + (lane >> 5); float v = sc >= 0 ? W[(size_t)(k0 + kk) * Nsrc + sc] : 0.f; if (kscale) v *= kscale[k0 + kk]; scr[kk * 33 + (lane & 31)] = v; }
    asm volatile("s_waitcnt lgkmcnt(0)" ::: "memory");
    const int c = lane & 7;
#pragma unroll
    for (int j = 0; j < 4; ++j) { const int n = (lane >> 3) + 8 * j; const LAS float* s = scr + (8 * c) * 33 + n;
        u32x4 o; o.x = cvtpk(s[0 * 33], s[1 * 33]); o.y = cvtpk(s[2 * 33], s[3 * 33]); o.z = cvtpk(s[4 * 33], s[5 * 33]); o.w = cvtpk(s[6 * 33], s[7 * 33]);
        *(u32x4*)(WT + (size_t)(n0 + n) * K + k0 + 8 * c) = o; }
    asm volatile("s_waitcnt lgkmcnt(0)" ::: "memory");
}
__device__ __forceinline__ void sincos_acc(float ang, float& c, float& s) {
    const double x = (double)ang; const double n = rint(x * 0.6366197723675814); const double r = (x - n * 1.5707963267341256) - n * 6.077100506506192e-11;
    const double r2 = r * r;
    double sp = r * (1.0 + r2 * (-1.0 / 6 + r2 * (1.0 / 120 + r2 * (-1.0 / 5040 + r2 * (1.0 / 362880 + r2 * (-1.0 / 39916800 + r2 * (1.0 / 6227020800.0)))))));
    double cp = 1.0 + r2 * (-0.5 + r2 * (1.0 / 24 + r2 * (-1.0 / 720 + r2 * (1.0 / 40320 + r2 * (-1.0 / 3628800 + r2 * (1.0 / 479001600.0 + r2 * (-1.0 / 87178291200.0)))))));
    const int q = ((int)n) & 3;
    const double ss = (q == 0) ? sp : (q == 1) ? cp : (q == 2) ? -sp : -cp;
    const double cc = (q == 0) ? cp : (q == 1) ? -sp : (q == 2) ? -cp : sp;
    c = (float)cc; s = (float)ss;
}

constexpr int CV_NI_GU = NE * 16 * 64, CV_NI = CV_NI_GU + NE * 16 * 32;
__device__ __forceinline__ void convert_experts(const float* __restrict__ WG, const float* __restrict__ WU, const float* __restrict__ WD, unsigned char* ws, LAS float* scr, int lane, int first, int step, int n) {
    const int kk = lane >> 3, nq = lane & 7;
    auto src_of = [&](int it) -> const float* {
        if (it < CV_NI_GU) { const int e = it / 1024, r = it % 1024, kb = r / 64, nb = r % 64; const int half = (nb >> 2) & 1; const int n0 = nb * 32;
            return (half ? WU : WG) + (size_t)e * 1024 * 1024 + (size_t)(64 * kb + kk) * 1024 + ((n0 >> 8) * 128 + (n0 & 127)) + 4 * nq; }
        const int i2 = it - CV_NI_GU; const int e = i2 / 512, r = i2 % 512, kb = r / 32, nb = r % 32;
        return WD + (size_t)e * 1024 * 1024 + (size_t)(64 * kb + kk) * 1024 + nb * 32 + 4 * nq; };
    f32x4 cur[8], nxt[8];
    int it = first;
    if (n > 0) { const float* p = src_of(it);
#pragma unroll
        for (int i = 0; i < 8; ++i) cur[i] = *(const f32x4*)(p + (size_t)i * 8 * 1024); }
#pragma unroll 1
    for (int c_ = 0; c_ < n; ++c_, it += step) {
        if (c_ + 1 < n) { const float* p = src_of(it + step);
#pragma unroll
            for (int i = 0; i < 8; ++i) nxt[i] = *(const f32x4*)(p + (size_t)i * 8 * 1024); }
#pragma unroll
        for (int i = 0; i < 8; ++i) { LAS float* d = scr + (8 * i + kk) * 33 + 4 * nq; d[0] = cur[i][0]; d[1] = cur[i][1]; d[2] = cur[i][2]; d[3] = cur[i][3]; }
        asm volatile("s_waitcnt lgkmcnt(0)" ::: "memory");
        unsigned char* wt; int kb, n0; float sc;
        if (it < CV_NI_GU) { const int e = it / 1024, r = it % 1024; kb = r / 64; n0 = (r % 64) * 32; wt = ws + WS_WGU + (size_t)e * 2048 * 1024; sc = WGU_SCALE; }
        else { const int i2 = it - CV_NI_GU; const int e = i2 / 512, r = i2 % 512; kb = r / 32; n0 = (r % 32) * 32; wt = ws + WS_WDN + (size_t)e * 1024 * 1024; sc = WDN_SCALE; }
        const int c = lane & 7;
#pragma unroll
        for (int j = 0; j < 4; ++j) { const int nn = (lane >> 3) + 8 * j; const LAS float* sp = scr + (8 * c) * 33 + nn;
            u32x2 o; o.x = pk4_fp8(sp[0 * 33] * sc, sp[1 * 33] * sc, sp[2 * 33] * sc, sp[3 * 33] * sc); o.y = pk4_fp8(sp[4 * 33] * sc, sp[5 * 33] * sc, sp[6 * 33] * sc, sp[7 * 33] * sc);
            *(u32x2*)(wt + (size_t)(n0 + nn) * 1024 + 64 * kb + 8 * c) = o; }
        asm volatile("s_waitcnt lgkmcnt(0)" ::: "memory");
#pragma unroll
        for (int i = 0; i < 8; ++i) cur[i] = nxt[i];
    }
}

__device__ __forceinline__ void steal_convert(const float* WG, const float* WU, const float* WD, unsigned char* ws, LAS unsigned char* lds, int tid, int wave, int lane, int max_grabs) {
    unsigned* qh = (unsigned*)(ws + WS_CTL) + CW_Q; volatile LAS unsigned* qs = (volatile LAS unsigned*)(lds + MISC_OFF + 128);
    LAS float* scr = (LAS float*)(lds + wave * 16384);
#pragma unroll 1
    for (int g = 0; g < max_grabs; ++g) {
        __syncthreads();
        if (tid == 0) *qs = __hip_atomic_fetch_add(qh, 64u, __ATOMIC_RELAXED, __HIP_MEMORY_SCOPE_AGENT);
        __syncthreads();
        const int base = __builtin_amdgcn_readfirstlane((int)*qs);
        if (base >= CV_NI) break;
        convert_experts(WG, WU, WD, ws, scr, lane, base + wave, 8, 8);
    }
}

struct Args { const float* in[22]; float* out; unsigned char* ws; float freq[32]; };
enum { I_X = 0, I_META, I_WIN, I_QG, I_WUQ, I_KVG, I_WUKV, I_MLAG, I_SBG, I_WO, I_LN1G, I_LN1B, I_WR, I_BR, I_WG, I_BG, I_WU, I_BU, I_WD, I_BD, I_LN2G, I_LN2B };

__global__ void __launch_bounds__(512, 2) fwd(Args args) {
    extern __shared__ __attribute__((aligned(16))) unsigned char lds_raw[];
    LAS unsigned char* lds = (LAS unsigned char*)lds_raw;
    volatile LAS unsigned* MISC = (volatile LAS unsigned*)(lds + MISC_OFF);
    const int G = gridDim.x, bx = blockIdx.x;
    const int wave_s = __builtin_amdgcn_readfirstlane((int)threadIdx.x >> 6);
#define LANE_ID() ([]() { int l_; asm volatile("v_mbcnt_lo_u32_b32 %0, -1, 0\n\tv_mbcnt_hi_u32_b32 %0, -1, %0" : "=v"(l_)); return l_; }())
#define LEADER() (wave_s == 0 && LANE_ID() == 0)
    for (int u = threadIdx.x; u < (LDS_BYTES - MISC_OFF) / 4; u += 512) MISC[u] = 0u;
    __syncthreads();
    XcdBarrier bar = xcd_barrier_post((unsigned*)(args.ws + WS_CTL) + CW_BAR, MISC, LEADER());
#define PH_LOCALS int lane_ = LANE_ID(); asm volatile("" : "+v"(lane_)); const int lane = lane_, wave = wave_s, tid = wave_s * 64 + lane_; \
    const int gw = bx * 8 + wave, NGW = G * 8, gt = bx * 512 + tid, NGT = G * 512; size_t z_; asm volatile("s_mov_b64 %0, 0" : "=s"(z_)); unsigned char* ws = args.ws + z_; \
    (void)lane; (void)tid; (void)gw; (void)NGW; (void)gt; (void)NGT; (void)ws;
#define W_(T, off) ((T*)(ws + (off)))

    {
        PH_LOCALS
        bf16_t* HB = W_(bf16_t, WS_HB);
        LAS float* scr = (LAS float*)(lds + wave * 16384);
        const int gwp = wave * G + bx;
        { const float* W = args.in[I_WIN];
          for (int it = gwp; it < 16 * 72; it += NGW) { const int kb = it / 72, nb = it % 72;
              transpose_item(W, 1024, 2112, W_(bf16_t, WS_WIN), scr, kb, nb * 32, lane, nullptr, [](int n) { return n < 512 ? n : (n < 2048 ? n + 64 : (n < 2112 ? 512 + ((n - 2048) >> 1) + 32 * ((n - 2048) & 1) : -1)); }); } }
        { const float* W = args.in[I_WUQ];
          for (int it = (gwp + NGW - 1664) % NGW; it < 4 * 24; it += NGW) { const int kb = it / 24, nb = it % 24;
              transpose_item(W, 256, 768, W_(bf16_t, WS_WUQ), scr, kb, nb * 32, lane, args.in[I_QG], [](int n) { const int hd = n / 192, d = n % 192; return d < 128 ? n : hd * 192 + 128 + ((d - 128) >> 1) + 32 * ((d - 128) & 1); }); } }
        { const float* W = args.in[I_WUKV];
          for (int it = (gwp + NGW - 1760) % NGW; it < 4 * 32; it += NGW) { const int kb = it / 32, nb = it % 32;
              transpose_item(W, 256, 1024, W_(bf16_t, WS_WUKV), scr, kb, nb * 32, lane, args.in[I_KVG], [](int n) { const int v = n >> 9, hd = (n & 511) >> 7, j = n & 127; return hd * 256 + v * 128 + j; }); } }
        { const float* W = args.in[I_WO];
          for (int it = (gwp + NGW - 1152) % NGW; it < 16 * 32; it += NGW) { const int kb = it / 32, nb = it % 32; transpose_item(W, 1024, 1024, W_(bf16_t, WS_WO), scr, kb, nb * 32, lane, kb < 8 ? args.in[I_MLAG] : args.in[I_SBG] - 512, [](int n) { return n; }); } }
        { const float* W = args.in[I_WR];
          for (int it = (gwp + NGW - 1888) % NGW; it < 16 * 8; it += NGW) { const int kb = it / 8, nb = it % 8; transpose_item(W, 1024, 32, W_(bf16_t, WS_WR), scr, kb, nb * 32, lane, nullptr, [](int n) { return n < 32 ? n : -1; }); } }
        { const float* x = args.in[I_X];
#pragma unroll 8
          for (size_t i = (size_t)gt; i < (size_t)MX * 128; i += NGT) { const f32x4 a = *(const f32x4*)(x + i * 8), b = *(const f32x4*)(x + i * 8 + 4); *(u32x4*)(HB + i * 8) = pack8(a, b, 1.f); }
          const float* mt = args.in[I_META];
          for (int i = gt; i < 256 * 128; i += NGT) { u32x4 w = (u32x4){0u, 0u, 0u, 0u}; if (i < NMETA * 128) { const f32x4 a = *(const f32x4*)(mt + (size_t)i * 8), b = *(const f32x4*)(mt + (size_t)i * 8 + 4); w = pack8(a, b, 1.f); }
              *(u32x4*)(HB + (size_t)MX * 1024 + (size_t)i * 8) = w; } }
        { float* ROPE = W_(float, WS_ROPE);
          for (int i = gt; i < NPOS * 32; i += NGT) { const int pos = i >> 5, k = i & 31; const float ang = (float)pos * args.freq[k]; float c, sn; sincos_acc(ang, c, sn); ROPE[(size_t)i * 2] = c; ROPE[(size_t)i * 2 + 1] = sn; } }
    }
    xcd_barrier(bar, LEADER());

    {
        PH_LOCALS
        pg8::SchedDense S; S.init(W_(bf16_t, WS_HB), W_(bf16_t, WS_WIN), 1024, 1024, MT, 2304, G, bx);
        EpiInProj E{ws, W_(float, WS_ROPE)};
        pg8::gemm_phase<EpiInProj, pg8::SchedDense, true>(lds, 2048, S, E, tid);
        if ((S.nwg - bx + G - 1) / G < (S.nwg + G - 1) / G) steal_convert(args.in[I_WG], args.in[I_WU], args.in[I_WD], ws, lds, tid, wave, lane, 2);
    }
    xcd_barrier(bar, LEADER());

    {
        PH_LOCALS
        pg8::SchedDense S; S.init(W_(bf16_t, R_CQ), W_(bf16_t, WS_WUQ), 256, 256, MX, 768, G, bx);
        EpiQ E{W_(bf16_t, R_Q)};
        pg8::gemm_phase<EpiQ, pg8::SchedDense, true>(lds, 512, S, E, tid);
    }
    {
        PH_LOCALS
        SchedKV S; S.init(W_(bf16_t, R_CKV), W_(bf16_t, WS_WUKV), 256, 256, MT, 1024, G, bx); S.ssq = W_(float, WS_SSQKV);
        EpiKV E{W_(bf16_t, R_K), W_(bf16_t, R_V), lds};
        pg8::gemm_phase<EpiKV, SchedKV, true, false, false, false, 4>(lds, 512, S, E, tid);
        if ((S.nwg - bx + G - 1) / G < (S.nwg + G - 1) / G) steal_convert(args.in[I_WG], args.in[I_WU], args.in[I_WD], ws, lds, tid, wave, lane, 1);
    }
    xcd_barrier(bar, LEADER());

    {
        PH_LOCALS
        const int vcu = (G % 8 == 0) ? (bx % 8) * (G / 8) + bx / 8 : bx;
        const int nmla = (G == 256) ? 4 : (1024 - bx + G - 1) / G;
#pragma unroll 1
        for (int i = 0; i < nmla; ++i) {
            int b, h, qb;
            if (G == 256) { const int bh = vcu >> 3, sx = vcu & 7; b = bh >> 2; h = bh & 3; qb = (i == 0) ? sx : (i == 1) ? 15 - sx : (i == 2) ? 16 + sx : 31 - sx; }
            else { const int u = bx + i * G; b = u >> 7; h = (u >> 5) & 3; qb = u & 31; }
            att::mla_unit(b, h, qb, W_(bf16_t, R_Q), W_(bf16_t, R_K), W_(bf16_t, R_V), W_(bf16_t, R_O), W_(float, R_SSQO), W_(float, WS_SSQQ), W_(float, WS_ROPE), lds, tid);
        }
#pragma unroll 1
        for (int u = vcu; u < 2048; u += G) att::sb_unit(u >> 8, (u >> 5) & 7, u & 31, W_(bf16_t, R_SBQ), W_(bf16_t, R_SBK), W_(bf16_t, R_SBV), W_(bf16_t, R_O), W_(float, R_SSQO), lds, tid);
        steal_convert(args.in[I_WG], args.in[I_WU], args.in[I_WD], ws, lds, tid, wave, lane, 1 << 20);
    }
    xcd_barrier(bar, LEADER());

    {
        PH_LOCALS
        SchedWo S; S.init(W_(bf16_t, R_O), W_(bf16_t, WS_WO), 1024, 1024, MX, 1024, G, bx); S.ssqo = W_(float, R_SSQO); S.ldsb = lds;
        EpiWoLN E{(bf16_t*)args.out, W_(bf16_t, WS_HB), W_(float, R_LNST), lds};
        pg8::gemm_phase<EpiWoLN, SchedWo, true, false, false, true>(lds, 2048, S, E, tid);
    }
    xcd_barrier(bar, LEADER());

    {
        PH_LOCALS
#pragma unroll 1
        for (int p = bx; p < MX / 256; p += G) {
            {
                bf16_t* HB = W_(bf16_t, WS_HB); unsigned char* H1Q = W_(unsigned char, WS_H1Q); const bf16_t* SG = (const bf16_t*)args.out;
                const float* g = args.in[I_LN1G]; const float* bb = args.in[I_LN1B];
                f32x4 gv[4], bv[4];
#pragma unroll
                for (int j = 0; j < 4; ++j) { gv[j] = *(const f32x4*)(g + lane * 8 + 512 * (j >> 1) + 4 * (j & 1)); bv[j] = *(const f32x4*)(bb + lane * 8 + 512 * (j >> 1) + 4 * (j & 1)); }
                float mean_l, rstd_l;
                { const f32x4* sp = (const f32x4*)(W_(float, R_LNST) + (size_t)(p * 256 + wave * 32 + (lane & 31)) * 32); float a1 = 0.f, a2 = 0.f;
#pragma unroll
                  for (int q = 0; q < 8; ++q) { const f32x4 t = sp[q]; a1 += t[0] + t[2]; a2 += t[1] + t[3]; }
                  mean_l = a1 * (1.f / 1024.f); const float var = fmaxf(a2 * (1.f / 1024.f) - mean_l * mean_l, 0.f); rstd_l = 1.f / sqrtf(var + LN_EPS); }
#pragma unroll 4
                for (int i = 0; i < 32; ++i) {
                    const int rl = wave * 32 + i; const size_t ro = (size_t)(p * 256 + rl) * 1024 + lane * 8;
                    const u32x4 w0 = *(const u32x4*)(SG + ro), w1 = *(const u32x4*)(SG + ro + 512);
                    const float mean = __shfl(mean_l, i), rstd = __shfl(rstd_l, i);
                    const f32x4 y0 = ((f32x4){bf_lo(w0.x), bf_hi(w0.x), bf_lo(w0.y), bf_hi(w0.y)} - mean) * rstd * gv[0] + bv[0], y1 = ((f32x4){bf_lo(w0.z), bf_hi(w0.z), bf_lo(w0.w), bf_hi(w0.w)} - mean) * rstd * gv[1] + bv[1];
                    const f32x4 y2 = ((f32x4){bf_lo(w1.x), bf_hi(w1.x), bf_lo(w1.y), bf_hi(w1.y)} - mean) * rstd * gv[2] + bv[2], y3 = ((f32x4){bf_lo(w1.z), bf_hi(w1.z), bf_lo(w1.w), bf_hi(w1.w)} - mean) * rstd * gv[3] + bv[3];
                    *(u32x4*)(HB + ro) = pack8(y0, y1, 1.f); *(u32x4*)(HB + ro + 512) = pack8(y2, y3, 1.f);
                    u32x2 q0, q1; q0.x = pk4_fp8(y0[0], y0[1], y0[2], y0[3]); q0.y = pk4_fp8(y1[0], y1[1], y1[2], y1[3]); q1.x = pk4_fp8(y2[0], y2[1], y2[2], y2[3]); q1.y = pk4_fp8(y3[0], y3[1], y3[2], y3[3]);
                    *(u32x2*)(H1Q + ro) = q0; *(u32x2*)(H1Q + ro + 512) = q1;
                }
            }
            __syncthreads();
            {
                SchedOne S; S.init(W_(bf16_t, WS_HB), W_(bf16_t, WS_WR), 1024, 1024, MX, 256, G, bx); S.p = p;
                EpiRouter E{args.in[I_BR], W_(unsigned, WS_CTL), W_(unsigned, WS_TOKBIN), W_(unsigned, WS_SLOT), W_(float, WS_GATEV)};
                pg8::gemm_phase<EpiRouter, SchedOne, false>(lds, 2048, S, E, tid);
            }
            __syncthreads();
        }
    }
    xcd_barrier(bar, LEADER());

    MoeTab T; T.cnt = (LAS int*)(lds + MISC_OFF + 256); T.ts = (LAS int*)(lds + MISC_OFF + 512); T.te = lds + MISC_OFF + 2048;
    if (LEADER()) { unsigned* ctl = (unsigned*)(args.ws + WS_CTL); int acc = 0; for (int e = 0; e < NE; ++e) { const int c = (int)__hip_atomic_load(ctl + CW_CNT + 64 * e, __ATOMIC_RELAXED, __HIP_MEMORY_SCOPE_AGENT); T.cnt[e] = c; T.ts[e] = acc; acc += (c + 255) >> 8; } T.ts[NE] = acc; }
    __syncthreads();
    { const int nt_ = T.ts[NE]; for (int t = wave_s * 64 + LANE_ID(); t < nt_; t += 512) { int e = 0; for (int k = 1; k < NE; ++k) if (t >= T.ts[k]) e = k; T.te[t] = (unsigned char)e; } }
    __syncthreads();

    {
        PH_LOCALS
        SchedGU S{(const char*)W_(unsigned char, WS_H1Q), (const char*)W_(unsigned char, WS_WGU), W_(unsigned, WS_TOKBIN), T, G, bx, T.ts[NE], args.in[I_BG], args.in[I_BU]};
        EpiGU E{lds, (unsigned char*)args.out, ws};
        pg8::gemm_phase<EpiGU, SchedGU, true, true, true, false, 1>(lds, 1024, S, E, tid);
    }
    xcd_barrier(bar, LEADER());

    {
        PH_LOCALS
        SchedDN S{(unsigned char*)args.out, ws, (const char*)W_(unsigned char, WS_WDN), T, G, bx, T.ts[NE], args.in[I_BD]};
        EpiDN E{lds, ws};
        pg8::gemm_phase<EpiDN, SchedDN, true, false, true, false, 1>(lds, 1024, S, E, tid);
    }
    xcd_barrier(bar, LEADER());

    {
        PH_LOCALS
        const bf16_t* HB = W_(bf16_t, WS_HB); const unsigned* SLOT = W_(unsigned, WS_SLOT); const float* GATEV = W_(float, WS_GATEV);
        const float* g = args.in[I_LN2G]; const float* bb = args.in[I_LN2B];
        f32x4 gv[4], bv[4];
#pragma unroll
        for (int j = 0; j < 4; ++j) { gv[j] = *(const f32x4*)(g + lane * 4 + 256 * j); bv[j] = *(const f32x4*)(bb + lane * 4 + 256 * j); }
#pragma unroll 2
        for (int m = gw; m < MX; m += NGW) {
            const u32x4 sl = *(const u32x4*)(SLOT + (size_t)m * 4); const f32x4 gt4 = *(const f32x4*)(GATEV + (size_t)m * 4);
            const u32x2* hr = (const u32x2*)(HB + (size_t)m * 1024) + lane;
            f32x4 v[4];
#pragma unroll
            for (int j = 0; j < 4; ++j) { const u32x2 w = hr[64 * j]; v[j] = (f32x4){bf_lo(w.x), bf_hi(w.x), bf_lo(w.y), bf_hi(w.y)} * DN_ALPHA; }
#pragma unroll
            for (int k = 0; k < 4; ++k) { const unsigned sk = sl[k]; const int e = (int)(sk >> 20), pos = (int)(sk & 0xfffffu); const int tile = T.ts[e] + (pos >> 8);
                const unsigned* yr = (const unsigned*)(y_tile_ptr(ws, tile) + (size_t)(pos & 255) * 1024) + lane; const float gk = gt4[k];
#pragma unroll
                for (int j = 0; j < 4; ++j) v[j] += unpk4_fp8(yr[64 * j]) * gk; }
            float s = 0.f;
#pragma unroll
            for (int j = 0; j < 4; ++j) s += (v[j][0] + v[j][1]) + (v[j][2] + v[j][3]);
            const float mean = wave_sum(s) * (1.f / 1024.f); float s2 = 0.f;
#pragma unroll
            for (int j = 0; j < 4; ++j) { v[j] = v[j] - mean; s2 += (v[j][0] * v[j][0] + v[j][1] * v[j][1]) + (v[j][2] * v[j][2] + v[j][3] * v[j][3]); }
            const float rstd = 1.f / sqrtf(wave_sum(s2) * (1.f / 1024.f) + LN_EPS);
            f32x4* orow = (f32x4*)(args.out + (size_t)m * 1024) + lane;
#pragma unroll
            for (int j = 0; j < 4; ++j) orow[64 * j] = v[j] * rstd * gv[j] + bv[j];
        }
    }
}

extern "C" void kernel_launch(void* const* d_in, const int* in_sizes, int n_in, void* d_out, int out_size, void* d_ws, size_t ws_size, hipStream_t stream) {
    static int grid = 0;
    static float freq[32];
    if (grid == 0) {
        if (n_in != 22 || in_sizes[0] != MX * DM || out_size != MX * DM || ws_size < WS_END) { fprintf(stderr, "kernel_launch: unexpected shapes (n_in %d, in0 %d, out %d, ws %zu)\n", n_in, n_in > 0 ? in_sizes[0] : -1, out_size, ws_size); grid = -1; return; }
        int dev = 0, cus = 0, per_cu = 0;
        if (hipGetDevice(&dev) != hipSuccess || hipDeviceGetAttribute(&cus, hipDeviceAttributeMultiprocessorCount, dev) != hipSuccess) { grid = -1; return; }
        if (hipFuncSetAttribute((const void*)fwd, hipFuncAttributeMaxDynamicSharedMemorySize, LDS_BYTES) != hipSuccess) { fprintf(stderr, "kernel_launch: hipFuncSetAttribute failed\n"); grid = -1; return; }
        if (hipOccupancyMaxActiveBlocksPerMultiprocessor(&per_cu, (const void*)fwd, 512, LDS_BYTES) != hipSuccess || per_cu < 1) fprintf(stderr, "kernel_launch: occupancy query reports %d\n", per_cu);
        (void)hipGetLastError();
        grid = cus;
        for (int i = 0; i < 32; ++i) freq[i] = (float)pow(10000.0, -(double)i / 32.0);
    }
    if (grid < 0) return;
    if (hipMemsetAsync((char*)d_ws + WS_CTL, 0, CTL_ZERO_BYTES, stream) != hipSuccess) return;
    Args a{};
    for (int i = 0; i < 22; ++i) a.in[i] = (const float*)d_in[i];
    a.out = (float*)d_out; a.ws = (unsigned char*)d_ws;
    for (int i = 0; i < 32; ++i) a.freq[i] = freq[i];
    hipLaunchKernelGGL(fwd, dim3(grid), dim3(512), LDS_BYTES, stream, a);
}
```

```cpp
#include <hip/hip_runtime.h>
#include <cstdio>
#include <cstdint>
#include <cmath>
#include <type_traits>

#define LAS __attribute__((address_space(3)))
#define GAS __attribute__((address_space(1)))
typedef unsigned short bf16_t;
typedef short bf16x8 __attribute__((ext_vector_type(8)));
typedef short s16x4 __attribute__((ext_vector_type(4)));
typedef float f32x4 __attribute__((ext_vector_type(4)));
typedef float f32x2 __attribute__((ext_vector_type(2)));
typedef float f32x16 __attribute__((ext_vector_type(16)));
typedef unsigned u32x4 __attribute__((ext_vector_type(4)));
typedef unsigned u32x2 __attribute__((ext_vector_type(2)));
typedef __bf16 bf16x2_t __attribute__((ext_vector_type(2)));

constexpr int NB = 8, SEQ = 8192, DM = 1024;
constexpr int MX = NB * SEQ;
constexpr int MT = MX + 256;
constexpr int NMETA = 16;
constexpr int NPOS = SEQ + NMETA;
constexpr int NE = 32, DFF = 1024;
constexpr int BINCAP = 65536;
constexpr float LOG2E = 1.4426950408889634f;
constexpr float DN_ALPHA = 1.189207115002721f;
constexpr float LN_EPS = 1e-5f, RMS_EPS = 1e-6f;
constexpr float QSCALE = 0.07216878364870322f * LOG2E;
constexpr float SBSCALE = 0.125f * LOG2E;

constexpr size_t MiB = 1u << 20;
constexpr size_t WS_CTL = 0, CTL_ZERO_BYTES = 1 * MiB;
constexpr size_t WS_ROPE = 1 * MiB;
constexpr size_t WS_METAF = 3 * MiB + MiB / 2;
constexpr size_t WS_WIN = 4 * MiB;
constexpr size_t WS_WUQ = 9 * MiB - MiB / 2;
constexpr size_t WS_WUKV = 9 * MiB;
constexpr size_t WS_WR = 10 * MiB - MiB / 2;
constexpr size_t WS_WO = 10 * MiB;
constexpr size_t WS_SSQQ = 12 * MiB;
constexpr size_t WS_SSQKV = 13 * MiB + MiB / 8;
constexpr size_t WS_SLOT = 14 * MiB + MiB / 2;
constexpr size_t WS_GATEV = 15 * MiB + MiB / 2;
constexpr size_t WS_TOKBIN = 17 * MiB;
constexpr size_t WS_WDN = 25 * MiB;
constexpr size_t WS_WGU = 57 * MiB;
constexpr size_t WS_HB = 121 * MiB;
constexpr size_t WS_H1Q = 250 * MiB;
constexpr size_t WS_R0 = 314 * MiB;
constexpr size_t R_CQ = WS_R0, R_CKV = WS_R0 + 33 * MiB, R_SBQ = WS_R0 + 66 * MiB, R_SBK = WS_R0 + 131 * MiB, R_SBV = WS_R0 + 196 * MiB;
constexpr size_t R_Q = WS_R0 + 261 * MiB, R_K = WS_R0 + 358 * MiB, R_V = WS_R0 + 455 * MiB, R_O = WS_R0 + 520 * MiB;
constexpr size_t R_SSQO = WS_R0 + 650 * MiB;
constexpr size_t R_LNST = WS_R0 + 656 * MiB;
constexpr size_t R_A2 = WS_R0, R_Y = WS_R0 + 8 * MiB;
constexpr size_t R_S = WS_R0 + 272 * MiB;
constexpr size_t R_MR = WS_SSQQ;
constexpr size_t WS_RC = 3 * MiB + MiB / 2 + 65536;
constexpr size_t WS_END = 1024 * MiB;
constexpr int A_TILES0 = 1024, MAX_TILES = 1055;
constexpr float WGU_SCALE = 32.f, WDN_SCALE = 64.f;
static_assert(R_O + (size_t)MX * 1024 * 2 <= WS_END && R_CQ + (size_t)MT * 512 <= R_CKV && R_CKV + (size_t)MT * 512 <= R_SBQ && R_SBQ + (size_t)MT * 1024 <= R_SBK && R_SBV + (size_t)MT * 1024 <= R_Q && R_Q + (size_t)MX * 1536 <= R_K && R_K + (size_t)MT * 1536 <= R_V && R_V + (size_t)MT * 1024 <= R_O, "attention region");
static_assert(WS_ROPE + (size_t)NPOS * 32 * 8 <= WS_METAF && WS_METAF + 16 * 256 * 4 <= WS_WIN, "meta scratch");
static_assert(R_S >= R_Y + (size_t)MAX_TILES * 262144 && R_S + (size_t)MX * 2048 <= R_O && R_MR + (size_t)MX * 8 <= WS_SSQKV && WS_RC + 256 <= WS_WIN, "s / mr / rc");
static_assert(R_LNST >= R_SSQO + (size_t)MX * 64 && R_LNST + (size_t)MX * 128 <= WS_END, "ln stats");
static_assert(R_SSQO >= R_O + (size_t)MX * 2048 && R_SSQO + (size_t)MX * 64 <= WS_END && R_Y + (size_t)MAX_TILES * 262144 <= WS_END && R_A2 + (size_t)(MAX_TILES - A_TILES0) * 262144 <= R_Y, "moe region");
static_assert(WS_GATEV + (size_t)MX * 16 <= WS_TOKBIN && WS_SLOT + (size_t)MX * 16 <= WS_GATEV && WS_TOKBIN + (size_t)NE * BINCAP * 4 <= WS_WDN && WS_WDN + (size_t)NE * 1024 * 1024 <= WS_WGU && WS_WGU + (size_t)NE * 2048 * 1024 <= WS_HB && WS_ROPE + (size_t)NPOS * 32 * 8 <= WS_WIN && WS_WIN + (size_t)2304 * 2048 <= WS_WUQ && WS_WUQ + 768 * 512 <= WS_WUKV && WS_WUKV + 1024 * 512 <= WS_WR && WS_WR + 256 * 2048 <= WS_WO && WS_WO + 1024 * 2048 <= WS_SSQQ, "map2");
static_assert(R_SBK - R_SBQ == R_SBV - R_SBK && WS_HB + (size_t)MT * 2048 <= WS_H1Q && WS_H1Q + (size_t)MX * 1024 <= WS_R0 && WS_SSQQ + (size_t)MT * 16 <= WS_SSQKV && WS_SSQKV + (size_t)MT * 16 <= WS_SLOT, "map");
constexpr int CW_BAR = 4096;
constexpr int CW_CNT = 16384;
constexpr int CW_Q = 8192;

constexpr int RING_BYTES = 131072;
constexpr int MISC_OFF = RING_BYTES;
constexpr int AUX_OFF = MISC_OFF + 4096;
constexpr int RS_OFF = MISC_OFF + 8192;
constexpr int MR_OFF = MISC_OFF + 14336;
constexpr int LDS_BYTES = 147456;

__device__ __forceinline__ unsigned cvtpk(float lo, float hi) { f32x2 v = {lo, hi}; bf16x2_t b = __builtin_convertvector(v, bf16x2_t); return __builtin_bit_cast(unsigned, b); }
__device__ __forceinline__ float bf_lo(unsigned w) { return __uint_as_float(w << 16); }
__device__ __forceinline__ float bf_hi(unsigned w) { return __uint_as_float(w & 0xffff0000u); }
__device__ __forceinline__ float wave_sum(float v) {
#pragma unroll
    for (int o = 1; o < 64; o <<= 1) v += __shfl_xor(v, o);
    return v;
}
__device__ __forceinline__ unsigned pk4_fp8(float a, float b, float c, float d) { int w = __builtin_amdgcn_cvt_pk_fp8_f32(a, b, 0, false); w = __builtin_amdgcn_cvt_pk_fp8_f32(c, d, w, true); return (unsigned)w; }
__device__ __forceinline__ f32x4 unpk4_fp8(unsigned w) { const f32x2 lo = __builtin_amdgcn_cvt_pk_f32_fp8((int)w, false), hi = __builtin_amdgcn_cvt_pk_f32_fp8((int)w, true); return (f32x4){lo[0], lo[1], hi[0], hi[1]}; }
__device__ __forceinline__ float ex2(float x) { return __builtin_amdgcn_exp2f(x); }
__device__ __forceinline__ float lg2(float x) { return __builtin_amdgcn_logf(x); }

namespace pg8 {
constexpr int BM = 256, BK = 64, HALF = 128, HTB = HALF * BK * 2, STAGE_BYTES = 8 * HTB, NXCD = 8, WGM = 8;
__host__ __device__ __forceinline__ int lds_byte(int r, int c) { const int st = (r >> 4) * 2 + (c >> 5), rr = r & 15, cc = c & 31, ob = rr * 64 + cc * 2; return st * 1024 + (ob ^ (((ob >> 9) & 1) << 5)); }
__host__ __device__ __forceinline__ void stage_rc(int b, int& R, int& C) { const int st = b / 1024, sb = b % 1024, swz = sb ^ (((sb >> 9) & 1) << 5); R = (st >> 1) * 16 + swz / 64; C = (st & 1) * 32 + (swz % 64) / 2; }
__host__ __device__ __forceinline__ int perm32(int rho) { const int n = rho >> 4, i = rho & 15; return 8 * (i >> 2) + 4 * n + (i & 3); }

struct Unit { int pm, pn, e, r0, slot; };

struct SchedDense {
    const char* A; const char* Bt; int lda, K; int nM, nN, nwg, G, c;
    __device__ void init(const void* A_, const void* Bt_, int lda_, int K_, int M, int N, int G_, int c_) { A = (const char*)A_; Bt = (const char*)Bt_; lda = lda_ * 2; K = K_ * 2; nM = M / BM; nN = N / BM; nwg = nM * nN; G = G_; c = c_; }
    __device__ __forceinline__ bool next(int i, Unit& u) const {
        const long L = (long)i * G + c; if (L >= nwg) return false;
        int wgid = (int)L; { const int q = nwg / NXCD, r = nwg % NXCD, xcd = wgid % NXCD, off = wgid / NXCD; wgid = (xcd < r ? xcd * (q + 1) : r * (q + 1) + (xcd - r) * q) + off; }
        const int nig = WGM * nN, gid = wgid / nig, fm = gid * WGM, gsz = (nM - fm) < WGM ? (nM - fm) : WGM;
        u.pm = fm + ((wgid % nig) % gsz); u.pn = (wgid % nig) / gsz; u.e = 0; u.r0 = 0; return true;
    }
    __device__ __forceinline__ int lda_() const { return lda; }
    __device__ __forceinline__ const char* a_base(const Unit& u) const { return A + (size_t)u.pm * BM * lda; }
    __device__ __forceinline__ const char* b_base(const Unit& u) const { return Bt + (size_t)u.pn * BM * K; }
    __device__ __forceinline__ void a_offs(const Unit&, unsigned (&vo)[2][2], const int (&R)[2], const int (&C)[2]) const {
#pragma unroll
        for (int h = 0; h < 2; ++h)
#pragma unroll
            for (int i = 0; i < 2; ++i) vo[h][i] = (unsigned)((h * HALF + R[i]) * lda + C[i] * 2);
    }
};

__device__ __forceinline__ void glds16(const char* sbase, unsigned voff, unsigned lds_dst) {
    unsigned keep;
    asm volatile("s_mov_b32 %0, m0\n\ts_mov_b32 m0, %3\n\ts_nop 2\n\tglobal_load_lds_dwordx4 %1, %2\n\ts_mov_b32 m0, %0" : "=&s"(keep) : "v"(voff), "s"(sbase), "s"(lds_dst) : "memory");
}
#define PG8_WAIT_V(n) asm volatile("s_waitcnt vmcnt(" #n ")" ::: "memory")
#define PG8_WAIT_L(n) asm volatile("s_waitcnt lgkmcnt(" #n ")" ::: "memory")
#define PG8_BAR __builtin_amdgcn_s_barrier()
#define PG8_SCHED __builtin_amdgcn_sched_barrier(0)

typedef int i32x8 __attribute__((ext_vector_type(8)));
typedef int i32x4 __attribute__((ext_vector_type(4)));
template <class Epi, class Sched, bool ALIGN_EPI, bool GATHER = false, bool F8 = false, bool ROWSCALE = false, int AUX = 0>
__device__ __forceinline__ void gemm_phase(LAS unsigned char* lds, const int K, const Sched& S, const Epi& E, int tid_) {
    asm volatile("" : "+v"(tid_));
    const int tid = tid_, wid = __builtin_amdgcn_readfirstlane(tid >> 6), lane = tid & 63, wr = wid >> 2, wc = wid & 3, fr = lane & 15, fq = lane >> 4;
    const int nt = K / (BK * 2);
    int sR[2], sC[2]; unsigned voffB[2], voffA[2];
#pragma unroll
    for (int i = 0; i < 2; ++i) { int R, C; stage_rc(tid * 16 + i * 8192, R, C); sR[i] = R; sC[i] = C; const int Rb = Epi::PERM ? ((R & ~31) + perm32(R & 31)) : R; voffB[i] = (unsigned)(Rb * K + C * 2); voffA[i] = (unsigned)(R * S.lda_() + C * 2); }
    const size_t kstep = (size_t)(BK * 2);
    const size_t hstepB = (size_t)HALF * K;
    const size_t hstepA = GATHER ? 0 : (size_t)HALF * S.lda_();
    const unsigned ldsw = (unsigned)wid * 1024u;
    const unsigned ldsd = (unsigned)__builtin_amdgcn_readfirstlane((int)((unsigned)(unsigned long)lds + ldsw));
    const int aoff = lds_byte(wr * 64 + fr, fq * 8), boff = lds_byte(wc * 32 + fr, fq * 8);
#define PG8_SA(b, h) (((b) * 2 + (h)) * HTB)
#define PG8_SB(b, h) ((4 + (b) * 2 + (h)) * HTB)
#define PG8_STAGE(bufoff, gbase, voff) do { _Pragma("unroll") for (int _i = 0; _i < 2; ++_i) \
        glds16((const char*)(gbase), (voff)[_i], ldsd + (unsigned)((bufoff) + _i * 8192)); } while (0)
#define PG8_STAGE_A(bufoff, gbase, h, vset) do { if constexpr (GATHER) { PG8_STAGE(bufoff, gbase, (vset)[h]); } else { PG8_STAGE(bufoff, (gbase) + (h) * hstepA, voffA); } } while (0)
#define PG8_LDA(dst, b, h) do { _Pragma("unroll") for (int m = 0; m < 4; ++m) _Pragma("unroll") for (int k = 0; k < 2; ++k) dst[m][k] = *(const LAS bf16x8*)(lds + PG8_SA(b, h) + aoff + m * 2048 + k * 1024); } while (0)
#define PG8_LDB(dst, b, h) do { _Pragma("unroll") for (int n = 0; n < 2; ++n) _Pragma("unroll") for (int k = 0; k < 2; ++k) dst[n][k] = *(const LAS bf16x8*)(lds + PG8_SB(b, h) + boff + n * 2048 + k * 1024); } while (0)
#define PG8_CAT(x) __builtin_shufflevector(__builtin_bit_cast(i32x4, (x)[0]), __builtin_bit_cast(i32x4, (x)[1]), 0, 1, 2, 3, 4, 5, 6, 7)
#define PG8_MMA(ai, bj, At, Bt) do { __builtin_amdgcn_s_setprio(1); _Pragma("unroll") for (int m = 0; m < 4; ++m) _Pragma("unroll") for (int n = 0; n < 2; ++n) { \
        if constexpr (F8) { acc[ai][bj][m][n] = __builtin_amdgcn_mfma_scale_f32_16x16x128_f8f6f4(PG8_CAT(Bt[n]), PG8_CAT(At[m]), acc[ai][bj][m][n], 0, 0, 0, 0, 0, 0); } \
        else { _Pragma("unroll") for (int k = 0; k < 2; ++k) acc[ai][bj][m][n] = __builtin_amdgcn_mfma_f32_16x16x32_bf16(Bt[n][k], At[m][k], acc[ai][bj][m][n], 0, 0, 0); } } __builtin_amdgcn_s_setprio(0); } while (0)
    Unit cur, nxt; int ui = 0;
    if (!S.next(0, cur)) return;
    f32x4 acc[2][2][4][2];
#pragma unroll
    for (int a = 0; a < 2; ++a)
#pragma unroll
        for (int b = 0; b < 2; ++b)
#pragma unroll
            for (int m = 0; m < 4; ++m)
#pragma unroll
                for (int n = 0; n < 2; ++n) acc[a][b][m][n] = (f32x4){0.f, 0.f, 0.f, 0.f};
    bf16x8 At[4][2], B0[2][2], B1[2][2];
    const char* cA = S.a_base(cur); const char* cB = S.b_base(cur);
    unsigned vc[2][2], vn[2];
    if constexpr (ROWSCALE) S.prep(cur, 0, tid);
    if constexpr (AUX == 1) { if (tid < 256) ((LAS float*)(lds + AUX_OFF))[tid] = *S.aux_src(cur, tid); }
    if constexpr (AUX == 4) { if (tid < 256) ((LAS float*)(lds + AUX_OFF))[tid] = S.aux_xform(*S.aux_src4(cur, tid)); }
    if constexpr (GATHER) { S.a_toks(cur, vn, sR); vc[0][0] = (vn[0] & 0xffffu) * 1024u + sC[0] * 2; vc[0][1] = (vn[0] >> 16) * 1024u + sC[1] * 2; vc[1][0] = (vn[1] & 0xffffu) * 1024u + sC[0] * 2; vc[1][1] = (vn[1] >> 16) * 1024u + sC[1] * 2; }
    PG8_STAGE(PG8_SB(0, 0), cB, voffB); PG8_STAGE(PG8_SB(0, 1), cB + hstepB, voffB); PG8_STAGE_A(PG8_SA(0, 0), cA, 0, vc); PG8_STAGE_A(PG8_SA(0, 1), cA, 1, vc);
    if (wr == 1) PG8_BAR;
    PG8_WAIT_V(2); PG8_BAR;
    PG8_STAGE(PG8_SB(1, 0), cB + kstep, voffB); PG8_STAGE_A(PG8_SA(1, 0), cA + kstep, 0, vc); PG8_STAGE(PG8_SB(1, 1), cB + hstepB + kstep, voffB);
    PG8_WAIT_V(6); PG8_BAR;
    for (;;) {
        const bool has_next = S.next(ui + 1, nxt);
        const char* nA = has_next ? S.a_base(nxt) : cA; const char* nB = has_next ? S.b_base(nxt) : cB;
        unsigned tk0 = 0u, tk1 = 0u, tk2 = 0u, tk3 = 0u;
        if constexpr (GATHER) { if (has_next) { const unsigned* q0 = S.a_tok_ptr(nxt, 0, sR[0]); const unsigned* q1 = S.a_tok_ptr(nxt, 0, sR[1]); const unsigned* q2 = S.a_tok_ptr(nxt, 1, sR[0]); const unsigned* q3 = S.a_tok_ptr(nxt, 1, sR[1]);
            asm volatile("global_load_dword %0, %4, off\n\tglobal_load_dword %1, %5, off\n\tglobal_load_dword %2, %6, off\n\tglobal_load_dword %3, %7, off" : "=&v"(tk0), "=&v"(tk1), "=&v"(tk2), "=&v"(tk3) : "v"(q0), "v"(q1), "v"(q2), "v"(q3) : "memory"); } }
        f32x4 rsa = (f32x4){0.f, 0.f, 0.f, 0.f}, rsb = rsa, rsc = rsa;
        if constexpr (ROWSCALE) { if (has_next && tid < 256) { const float* rp_ = S.rs_src(nxt, tid); asm volatile("global_load_dwordx4 %0, %3, off\n\tglobal_load_dwordx4 %1, %3, off offset:16\n\tglobal_load_dwordx4 %2, %3, off offset:32" : "=&v"(rsa), "=&v"(rsb), "=&v"(rsc) : "v"(rp_) : "memory"); } }
        float auxv = 0.f; f32x4 auxv4 = (f32x4){0.f, 0.f, 0.f, 0.f};
        if constexpr (AUX == 1) { if (has_next && tid < 256) { const float* ap_ = S.aux_src(nxt, tid); asm volatile("global_load_dword %0, %1, off" : "=&v"(auxv) : "v"(ap_) : "memory"); } }
        if constexpr (AUX == 4) { if (has_next && tid < 256) { const f32x4* ap_ = S.aux_src4(nxt, tid); asm volatile("global_load_dwordx4 %0, %1, off" : "=&v"(auxv4) : "v"(ap_) : "memory"); } }
#pragma unroll 1
        for (int t = 0; t < nt; t += 2) {
            const bool last = (t == nt - 2);
            if constexpr (ROWSCALE) { if (t == nt / 2) { const LAS f32x2* rsl = (const LAS f32x2*)(lds + RS_OFF) + (ui % 3) * 256 + wr * 64 + (lane & 15);
#pragma unroll
                for (int ai = 0; ai < 2; ++ai)
#pragma unroll
                    for (int m = 0; m < 4; ++m) { const float rt = rsl[ai * 128 + m * 16][0];
#pragma unroll
                        for (int bj = 0; bj < 2; ++bj)
#pragma unroll
                            for (int n = 0; n < 2; ++n) acc[ai][bj][m][n] *= rt; } } }
            const char* a1 = cA + (size_t)(t + 1) * kstep;
            const char* a2 = last ? nA : cA + (size_t)(t + 2) * kstep; const char* b2 = last ? nB : cB + (size_t)(t + 2) * kstep;
            const char* a3 = a2 + kstep; const char* b3 = b2 + kstep;
            PG8_LDB(B0, 0, 0); PG8_LDB(B1, 0, 1); PG8_SCHED; PG8_LDA(At, 0, 0); PG8_STAGE_A(PG8_SA(1, 1), a1, 1, vc);
            if constexpr (GATHER) { if (last && has_next) { vc[0][0] = (vn[0] & 0xffffu) * 1024u + sC[0] * 2; vc[0][1] = (vn[0] >> 16) * 1024u + sC[1] * 2; vc[1][0] = (vn[1] & 0xffffu) * 1024u + sC[0] * 2; vc[1][1] = (vn[1] >> 16) * 1024u + sC[1] * 2; } }
            PG8_WAIT_V(8); PG8_WAIT_L(0); PG8_BAR; PG8_MMA(0, 0, At, B0); PG8_MMA(0, 1, At, B1); PG8_BAR; PG8_SCHED;
            PG8_LDA(At, 0, 1); PG8_STAGE(PG8_SB(0, 0), b2, voffB); PG8_STAGE(PG8_SB(0, 1), b2 + hstepB, voffB); PG8_STAGE_A(PG8_SA(0, 0), a2, 0, vc);
            PG8_WAIT_V(8);
            if constexpr (ROWSCALE) { if (t == 0 && has_next && tid < 256) { asm volatile("" : "+v"(rsa), "+v"(rsb), "+v"(rsc)); ((LAS f32x2*)(lds + RS_OFF))[((ui + 1) % 3) * 256 + tid] = S.rs_xform(rsa, rsb, rsc); } }
            if constexpr (GATHER) { if (t == 0 && has_next) { asm volatile("" : "+v"(tk0), "+v"(tk1), "+v"(tk2), "+v"(tk3)); vn[0] = tk0 | (tk1 << 16); vn[1] = tk2 | (tk3 << 16); } }
            if constexpr (AUX == 1) { if (t == 0 && has_next && tid < 256) { asm volatile("" : "+v"(auxv)); ((LAS float*)(lds + AUX_OFF))[((ui + 1) % 3) * 256 + tid] = auxv; } }
            if constexpr (AUX == 4) { if (t == 0 && has_next && tid < 256) { asm volatile("" : "+v"(auxv4)); ((LAS float*)(lds + AUX_OFF))[((ui + 1) % 3) * 256 + tid] = S.aux_xform(auxv4); } }
            PG8_WAIT_L(0); PG8_BAR; PG8_MMA(1, 0, At, B0); PG8_MMA(1, 1, At, B1); PG8_BAR; PG8_SCHED;
            PG8_LDB(B0, 1, 0); PG8_LDB(B1, 1, 1); PG8_SCHED; PG8_LDA(At, 1, 0); PG8_STAGE_A(PG8_SA(0, 1), a2, 1, vc);
            PG8_WAIT_V(8); PG8_WAIT_L(0); PG8_BAR; PG8_MMA(0, 0, At, B0); PG8_MMA(0, 1, At, B1); PG8_BAR; PG8_SCHED;
            PG8_LDA(At, 1, 1); PG8_STAGE(PG8_SB(1, 0), b3, voffB); PG8_STAGE(PG8_SB(1, 1), b3 + hstepB, voffB); PG8_STAGE_A(PG8_SA(1, 0), a3, 0, vc);
            PG8_WAIT_V(8); PG8_WAIT_L(0); PG8_BAR; PG8_MMA(1, 0, At, B0); PG8_MMA(1, 1, At, B1); PG8_BAR; PG8_SCHED;
        }
        if constexpr (ALIGN_EPI) { if (wr == 0) PG8_BAR; }
        if constexpr (!Epi::AFTER_DRAIN) { int l2 = lane; asm volatile("" : "+v"(l2)); cur.slot = ui % 3; if constexpr (ROWSCALE) cur.r0 = ui % 3; E(acc, cur, wr, wc, l2 & 15, l2 >> 4); }
        if (!has_next) break;
#pragma unroll
        for (int a = 0; a < 2; ++a)
#pragma unroll
            for (int b = 0; b < 2; ++b)
#pragma unroll
                for (int m = 0; m < 4; ++m)
#pragma unroll
                    for (int n = 0; n < 2; ++n) acc[a][b][m][n] = (f32x4){0.f, 0.f, 0.f, 0.f};
        cur = nxt; cA = nA; cB = nB; ++ui;
        if constexpr (ALIGN_EPI) { if (wr == 1) PG8_BAR; }
    }
    PG8_WAIT_V(0);
    if constexpr (!ALIGN_EPI) { if (wr == 0) PG8_BAR; }
    PG8_BAR;
    if constexpr (Epi::AFTER_DRAIN) { E.fused(acc, cur, wr, wc, fr, fq, lds, wid, lane); }
#undef PG8_SA
#undef PG8_SB
#undef PG8_STAGE
#undef PG8_STAGE_A
#undef PG8_LDA
#undef PG8_LDB
#undef PG8_MMA
#undef PG8_CAT
}
}

typedef f32x4 acc_t[2][2][4][2];

__device__ __forceinline__ u32x4 pack8(const f32x4 a, const f32x4 b, float s) {
    u32x4 w; w.x = cvtpk(a[0] * s, a[1] * s); w.y = cvtpk(a[2] * s, a[3] * s); w.z = cvtpk(b[0] * s, b[1] * s); w.w = cvtpk(b[2] * s, b[3] * s); return w;
}
__device__ __forceinline__ void rope8(f32x4& a, f32x4& b, const f32x4 cs0, const f32x4 cs1) {
    const float x0 = a[0], x1 = a[1], x2 = a[2], x3 = a[3], y0 = b[0], y1 = b[1], y2 = b[2], y3 = b[3];
    a[0] = x0 * cs0[0] - x1 * cs0[1]; a[1] = x1 * cs0[0] + x0 * cs0[1];
    a[2] = x2 * cs0[2] - x3 * cs0[3]; a[3] = x3 * cs0[2] + x2 * cs0[3];
    b[0] = y0 * cs1[0] - y1 * cs1[1]; b[1] = y1 * cs1[0] + y0 * cs1[1];
    b[2] = y2 * cs1[2] - y3 * cs1[3]; b[3] = y3 * cs1[2] + y2 * cs1[3];
}
__device__ __forceinline__ int row_pos(int row) { return row < MX ? NMETA + (row & (SEQ - 1)) : ((row - MX) < NPOS ? (row - MX) : NPOS - 1); }

struct EpiInProj {
    static constexpr bool PERM = true, AFTER_DRAIN = false;
    unsigned char* ws; const float* rope;
    __device__ __forceinline__ void operator()(const acc_t& acc, const pg8::Unit& u, int wr, int wc, int fr, int fq) const {
        const int pn = u.pn; const int rowb = u.pm * 256 + wr * 64 + fr;
        if (pn <= 1) {
            bf16_t* dst = (bf16_t*)(ws + R_CQ + (size_t)pn * (R_CKV - R_CQ)); float* ssq = (float*)(ws + WS_SSQQ + (size_t)pn * (WS_SSQKV - WS_SSQQ));
#pragma unroll
            for (int ai = 0; ai < 2; ++ai)
#pragma unroll
                for (int m = 0; m < 4; ++m) { const int row = rowb + ai * 128 + m * 16; float s = 0.f;
#pragma unroll
                    for (int bj = 0; bj < 2; ++bj) { const f32x4 v0 = acc[ai][bj][m][0], v1 = acc[ai][bj][m][1];
                        s += (v0[0] * v0[0] + v0[1] * v0[1]) + (v0[2] * v0[2] + v0[3] * v0[3]) + (v1[0] * v1[0] + v1[1] * v1[1]) + (v1[2] * v1[2] + v1[3] * v1[3]);
                        *(u32x4*)(dst + (size_t)row * 256 + bj * 128 + wc * 32 + 8 * fq) = pack8(v0, v1, 1.f); }
                    s += __shfl_xor(s, 16); s += __shfl_xor(s, 32);
                    if (fq == 0) ssq[(size_t)row * 4 + wc] = s; }
        } else if (pn <= 7) {
            const int t = pn - 2; bf16_t* dst = (bf16_t*)(ws + R_SBQ + (size_t)(t >> 1) * (R_SBK - R_SBQ)); const int colt = (t & 1) * 256; const float sc = t < 2 ? SBSCALE : 1.f;
#pragma unroll
            for (int ai = 0; ai < 2; ++ai)
#pragma unroll
                for (int m = 0; m < 4; ++m) { const int row = rowb + ai * 128 + m * 16;
#pragma unroll
                    for (int bj = 0; bj < 2; ++bj) *(u32x4*)(dst + (size_t)row * 512 + colt + bj * 128 + wc * 32 + 8 * fq) = pack8(acc[ai][bj][m][0], acc[ai][bj][m][1], sc); }
        } else {
            bf16_t* Kb = (bf16_t*)(ws + R_K);
            if (wc < 2) { const int c0 = 32 * wc + 8 * fq;
                f32x4 csr[2][4][2];
#pragma unroll
                for (int ai = 0; ai < 2; ++ai)
#pragma unroll
                    for (int m = 0; m < 4; ++m) { const int pos = row_pos(rowb + ai * 128 + m * 16); csr[ai][m][0] = *(const f32x4*)(rope + ((size_t)pos * 32 + (c0 >> 1)) * 2); csr[ai][m][1] = *(const f32x4*)(rope + ((size_t)pos * 32 + (c0 >> 1) + 2) * 2); }
#pragma unroll
                for (int ai = 0; ai < 2; ++ai)
#pragma unroll
                    for (int m = 0; m < 4; ++m) { const int row = rowb + ai * 128 + m * 16;
                        const f32x4 cs0 = csr[ai][m][0], cs1 = csr[ai][m][1];
                        f32x4 a = acc[ai][0][m][0], b = acc[ai][0][m][1]; rope8(a, b, cs0, cs1); const u32x4 w = pack8(a, b, 1.f);
#pragma unroll
                        for (int h = 0; h < 4; ++h) *(u32x4*)(Kb + (size_t)row * 768 + h * 192 + 128 + c0) = w; } }
        }
    }
};
struct EpiQ {
    static constexpr bool PERM = true, AFTER_DRAIN = false;
    bf16_t* Q;
    __device__ __forceinline__ void operator()(const acc_t& acc, const pg8::Unit& u, int wr, int wc, int fr, int fq) const {
        const int rowb = u.pm * 256 + wr * 64 + fr;
#pragma unroll
        for (int ai = 0; ai < 2; ++ai)
#pragma unroll
            for (int m = 0; m < 4; ++m) { bf16_t* rowp = Q + (size_t)(rowb + ai * 128 + m * 16) * 768 + u.pn * 256 + wc * 32 + 8 * fq;
#pragma unroll
                for (int bj = 0; bj < 2; ++bj) *(u32x4*)(rowp + bj * 128) = pack8(acc[ai][bj][m][0], acc[ai][bj][m][1], 1.f); }
    }
};
struct SchedKV : pg8::SchedDense {
    const float* ssq;
    __device__ __forceinline__ const f32x4* aux_src4(const pg8::Unit& u, int tid) const { return (const f32x4*)(ssq + (size_t)(u.pm * 256 + tid) * 4); }
    __device__ __forceinline__ float aux_xform(const f32x4 sq) const { return 1.f / sqrtf(((sq[0] + sq[1]) + (sq[2] + sq[3])) * (1.f / 256.f) + RMS_EPS); }
};
struct EpiKV {
    static constexpr bool PERM = true, AFTER_DRAIN = false;
    bf16_t *Kb, *Vb; LAS unsigned char* ldsb;
    __device__ __forceinline__ void operator()(const acc_t& acc, const pg8::Unit& u, int wr, int wc, int fr, int fq) const {
        const int rowb = u.pm * 256 + wr * 64 + fr; const LAS float* ax = (const LAS float*)(ldsb + AUX_OFF) + u.slot * 256 + wr * 64 + fr;
#pragma unroll
        for (int ai = 0; ai < 2; ++ai)
#pragma unroll
            for (int m = 0; m < 4; ++m) { const int row = rowb + ai * 128 + m * 16; const float rs = ax[ai * 128 + m * 16];
#pragma unroll
                for (int bj = 0; bj < 2; ++bj) { const int cc = (u.pn & 1) * 256 + bj * 128 + wc * 32 + 8 * fq;
                    bf16_t* p = u.pn < 2 ? Kb + (size_t)row * 768 + (u.pn * 2 + bj) * 192 + wc * 32 + 8 * fq : Vb + (size_t)row * 512 + cc;
                    *(u32x4*)p = pack8(acc[ai][bj][m][0], acc[ai][bj][m][1], rs); } }
    }
};
struct SchedWo : pg8::SchedDense {
    const float* ssqo; LAS unsigned char* ldsb;
    __device__ __forceinline__ const float* rs_src(const pg8::Unit& u, int tid) const { return ssqo + (size_t)(u.pm * 256 + tid) * 16; }
    __device__ __forceinline__ f32x2 rs_xform(const f32x4 a, const f32x4 b, const f32x4 c) const {
        const float rm = 1.f / sqrtf(((a[0] + a[1]) + (a[2] + a[3])) * (1.f / 512.f) + RMS_EPS), rs = 1.f / sqrtf((((b[0] + b[1]) + (b[2] + b[3])) + ((c[0] + c[1]) + (c[2] + c[3]))) * (1.f / 512.f) + RMS_EPS); return (f32x2){rm / rs, rs}; }
    __device__ __forceinline__ void prep(const pg8::Unit& u, int slot, int tid) const {
        if (tid < 256) { const float* p = ssqo + (size_t)(u.pm * 256 + tid) * 16; const f32x4 a = *(const f32x4*)p, b = *(const f32x4*)(p + 4), c = *(const f32x4*)(p + 8);
            const float rm = 1.f / sqrtf(((a[0] + a[1]) + (a[2] + a[3])) * (1.f / 512.f) + RMS_EPS), rs = 1.f / sqrtf((((b[0] + b[1]) + (b[2] + b[3])) + ((c[0] + c[1]) + (c[2] + c[3]))) * (1.f / 512.f) + RMS_EPS);
            ((LAS f32x2*)(ldsb + RS_OFF))[slot * 256 + tid] = (f32x2){rm / rs, rs}; }
    }
};
struct EpiWo {
    static constexpr bool PERM = true, AFTER_DRAIN = false;
    bf16_t* A; LAS unsigned char* ldsb;
    __device__ __forceinline__ void operator()(const acc_t& acc, const pg8::Unit& u, int wr, int wc, int fr, int fq) const {
        const int rowb = u.pm * 256 + wr * 64 + fr; const int col0 = u.pn * 256 + wc * 32 + 8 * fq;
        const LAS f32x2* rsl = (const LAS f32x2*)(ldsb + RS_OFF) + u.r0 * 256 + wr * 64 + fr;
#pragma unroll
        for (int ai = 0; ai < 2; ++ai)
#pragma unroll
            for (int m = 0; m < 4; ++m) { bf16_t* rowp = A + (size_t)(rowb + ai * 128 + m * 16) * 1024 + col0; const float rs = rsl[ai * 128 + m * 16][1];
#pragma unroll
                for (int bj = 0; bj < 2; ++bj) *(u32x4*)(rowp + bj * 128) = pack8(acc[ai][bj][m][0], acc[ai][bj][m][1], rs); }
    }
};
struct SchedOne : pg8::SchedDense {
    int p;
    __device__ __forceinline__ bool next(int i, pg8::Unit& u) const { if (i >= 1) return false; u.pm = p; u.pn = 0; u.e = 0; u.r0 = 0; return true; }
};
struct EpiWoLN {
    static constexpr bool PERM = true, AFTER_DRAIN = false;
    bf16_t* S; const bf16_t* XB; float* LNST; LAS unsigned char* ldsb;
    __device__ __forceinline__ void operator()(const acc_t& acc, const pg8::Unit& u, int wr, int wc, int fr, int fq) const {
        const int rl = wr * 64 + fr; const int col0 = u.pn * 256 + wc * 32 + 8 * fq;
        const LAS f32x2* rsl = (const LAS f32x2*)(ldsb + RS_OFF) + u.r0 * 256 + rl;
        f32x2* st = (f32x2*)LNST + (size_t)(u.pm * 256 + rl) * 16 + u.pn * 4 + wc;
        const size_t off0 = (size_t)(u.pm * 256 + rl) * 1024 + col0;
#pragma unroll
        for (int ai = 0; ai < 2; ++ai) {
            u32x4 xw[4][2];
#pragma unroll
            for (int m = 0; m < 4; ++m)
#pragma unroll
                for (int bj = 0; bj < 2; ++bj) xw[m][bj] = __builtin_nontemporal_load((const u32x4*)(XB + off0 + (size_t)(ai * 128 + m * 16) * 1024 + bj * 128));
#pragma unroll
            for (int m = 0; m < 4; ++m) { const int ro = ai * 128 + m * 16; const size_t off = off0 + (size_t)ro * 1024; const float rs = rsl[ro][1];
                float s1 = 0.f, s2 = 0.f;
#pragma unroll
                for (int bj = 0; bj < 2; ++bj) { const u32x4 x4 = xw[m][bj];
                    const f32x4 v0 = acc[ai][bj][m][0] * rs + (f32x4){bf_lo(x4.x), bf_hi(x4.x), bf_lo(x4.y), bf_hi(x4.y)} * DN_ALPHA, v1 = acc[ai][bj][m][1] * rs + (f32x4){bf_lo(x4.z), bf_hi(x4.z), bf_lo(x4.w), bf_hi(x4.w)} * DN_ALPHA;
                    s1 += ((v0[0] + v0[1]) + (v0[2] + v0[3])) + ((v1[0] + v1[1]) + (v1[2] + v1[3]));
                    s2 += ((v0[0] * v0[0] + v0[1] * v0[1]) + (v0[2] * v0[2] + v0[3] * v0[3])) + ((v1[0] * v1[0] + v1[1] * v1[1]) + (v1[2] * v1[2] + v1[3] * v1[3]));
                    *(u32x4*)(S + off + bj * 128) = pack8(v0, v1, 1.f); }
                s1 += __shfl_xor(s1, 16); s2 += __shfl_xor(s2, 16); s1 += __shfl_xor(s1, 32); s2 += __shfl_xor(s2, 32);
                if (fq == 0) st[(size_t)ro * 16] = (f32x2){s1, s2}; }
        }
    }
};
struct EpiRouter {
    static constexpr bool PERM = true, AFTER_DRAIN = true;
    const float* rc; unsigned* gcnt; unsigned* tokbin; unsigned* slot; float* gatev;
    __device__ __forceinline__ void fused(acc_t& acc, const pg8::Unit& u, int wr, int wc, int fr, int fq, LAS unsigned char* lds, int wid, int lane) const {
        LAS unsigned* lcnt = (LAS unsigned*)lds;
        LAS unsigned* lbase = (LAS unsigned*)(lds + 256);
        LAS float* lg = (LAS float*)(lds + 1024);
        const int tix = wid * 64 + lane;
        if (tix < 32) lcnt[tix] = 0u;
        if (wc == 0) {
#pragma unroll
            for (int ai = 0; ai < 2; ++ai)
#pragma unroll
                for (int m = 0; m < 4; ++m) { const f32x4 a = acc[ai][0][m][0], b = acc[ai][0][m][1]; LAS float* d = lg + (ai * 128 + wr * 64 + m * 16 + fr) * 33 + 8 * fq;
                    d[0] = a[0]; d[1] = a[1]; d[2] = a[2]; d[3] = a[3]; d[4] = b[0]; d[5] = b[1]; d[6] = b[2]; d[7] = b[3]; }
        }
        asm volatile("s_waitcnt lgkmcnt(0)" ::: "memory"); __builtin_amdgcn_s_barrier(); asm volatile("" ::: "memory");
        int ti[4]; unsigned rk[4]; float gk[4];
        if (tix < 256) {
            float v[32];
            { const f32x2 mr = ((const LAS f32x2*)(lds + MR_OFF))[tix];
#pragma unroll
              for (int j = 0; j < 32; ++j) v[j] = mr[1] * (lg[tix * 33 + j] - mr[0] * rc[j]) + rc[32 + j]; }
            float tv[4];
#pragma unroll
            for (int k = 0; k < 4; ++k) {
                float bv = v[0]; int bi = 0;
#pragma unroll
                for (int j = 1; j < 32; ++j) if (v[j] > bv) { bv = v[j]; bi = j; }
                tv[k] = bv; ti[k] = bi;
#pragma unroll
                for (int j = 0; j < 32; ++j) if (bi == j) v[j] = -INFINITY;
            }
            const float e1 = __expf(tv[1] - tv[0]), e2 = __expf(tv[2] - tv[0]), e3 = __expf(tv[3] - tv[0]); const float inv = 1.f / (1.f + e1 + e2 + e3);
            gk[0] = inv; gk[1] = e1 * inv; gk[2] = e2 * inv; gk[3] = e3 * inv;
#pragma unroll
            for (int k = 0; k < 4; ++k) rk[k] = __hip_atomic_fetch_add(lcnt + ti[k], 1u, __ATOMIC_RELAXED, __HIP_MEMORY_SCOPE_WORKGROUP);
        }
        asm volatile("s_waitcnt lgkmcnt(0)" ::: "memory"); __builtin_amdgcn_s_barrier(); asm volatile("" ::: "memory");
        if (tix < 32) { const unsigned c = lcnt[tix]; lbase[tix] = __hip_atomic_fetch_add(gcnt + CW_CNT + 64 * tix, c, __ATOMIC_RELAXED, __HIP_MEMORY_SCOPE_AGENT); }
        asm volatile("s_waitcnt vmcnt(0) lgkmcnt(0)" ::: "memory"); __builtin_amdgcn_s_barrier(); asm volatile("" ::: "memory");
        if (tix < 256) { const int row = u.pm * 256 + tix; u32x4 sl; f32x4 gv;
#pragma unroll
            for (int k = 0; k < 4; ++k) { const int e = ti[k]; const unsigned pos = lbase[e] + rk[k]; tokbin[(size_t)e * BINCAP + pos] = (unsigned)row; sl[k] = ((unsigned)e << 20) | pos; gv[k] = gk[k]; }
            *(u32x4*)(slot + (size_t)row * 4) = sl; *(f32x4*)(gatev + (size_t)row * 4) = gv; }
    }
};

struct MoeTab { LAS int* cnt; LAS int* ts; LAS unsigned char* te; };
__device__ __forceinline__ unsigned char* a_tile_ptr(unsigned char* dout, unsigned char* ws, int tile) { return tile < A_TILES0 ? dout + (size_t)tile * 262144 : ws + R_A2 + (size_t)(tile - A_TILES0) * 262144; }
__device__ __forceinline__ unsigned char* y_tile_ptr(unsigned char* ws, int tile) { return ws + R_Y + (size_t)tile * 262144; }

struct SchedGU {
    const char* H; const char* W; const unsigned* tokbin; MoeTab T; int G, c, NT;
    __device__ __forceinline__ bool next(int i, pg8::Unit& u) const {
        int tile, pn;
        if (G == 256) { const int x = c & 7, j = c >> 3; tile = i * 32 + x * 4 + (j >> 3); pn = j & 7; } else { const long L = (long)i * G + c; tile = (int)(L >> 3); pn = (int)(L & 7); }
        if (tile >= NT) return false;
        const int e = __builtin_amdgcn_readfirstlane((int)T.te[tile]);
        u.pm = tile; u.pn = pn; u.e = e; u.r0 = (tile - T.ts[e]) * 256; return true;
    }
    __device__ __forceinline__ int lda_() const { return 1024; }
    __device__ __forceinline__ const char* a_base(const pg8::Unit&) const { return H; }
    __device__ __forceinline__ const char* b_base(const pg8::Unit& u) const { return W + ((size_t)u.e * 2048 + (size_t)u.pn * 256) * 1024; }
    const float *b_gate, *b_up;
    __device__ __forceinline__ const float* aux_src(const pg8::Unit& u, int tid) const { return (tid < 128 ? b_gate : b_up - 128) + u.e * DFF + u.pn * 128 + tid; }
    __device__ __forceinline__ const unsigned* a_tok_ptr(const pg8::Unit& u, int h, int R) const { const int n = T.cnt[u.e]; int r = u.r0 + h * 128 + R; r = r < n ? r : n - 1; return tokbin + (size_t)u.e * BINCAP + r; }
    __device__ __forceinline__ void a_toks(const pg8::Unit& u, unsigned (&vt)[2], const int (&R)[2]) const {
        const int n = T.cnt[u.e];
#pragma unroll
        for (int h = 0; h < 2; ++h) { const int r0 = u.r0 + h * 128 + R[0], r1 = u.r0 + h * 128 + R[1];
            const unsigned t0 = r0 < n ? tokbin[(size_t)u.e * BINCAP + r0] : 0u, t1 = r1 < n ? tokbin[(size_t)u.e * BINCAP + r1] : 0u; vt[h] = t0 | (t1 << 16); }
    }
};
struct EpiGU {
    static constexpr bool PERM = true, AFTER_DRAIN = false;
    LAS unsigned char* ldsb; unsigned char* dout; unsigned char* ws;
    __device__ __forceinline__ void operator()(const acc_t& acc, const pg8::Unit& u, int wr, int wc, int fr, int fq) const {
        const int col = u.pn * 128 + wc * 32 + 8 * fq;
        const LAS float* ax = (const LAS float*)(ldsb + AUX_OFF) + u.slot * 256 + wc * 32 + 8 * fq;
        const f32x4 bg0 = *(const LAS f32x4*)(ax), bg1 = *(const LAS f32x4*)(ax + 4), bu0 = *(const LAS f32x4*)(ax + 128), bu1 = *(const LAS f32x4*)(ax + 132);
        unsigned char* base = a_tile_ptr(dout, ws, u.pm) + (col - 8 * (fq & 1));
#pragma unroll
        for (int ai = 0; ai < 2; ++ai) { u32x2 wq[4];
#pragma unroll
            for (int m = 0; m < 4; ++m) { const int r = ai * 128 + wr * 64 + m * 16 + fr; float o[8];
#pragma unroll
                for (int n = 0; n < 2; ++n)
#pragma unroll
                    for (int hf = 0; hf < 2; ++hf) {
                        const f32x4 ag = acc[ai][0][m][n], au = acc[ai][1][m][n], bg = n ? bg1 : bg0, bu = n ? bu1 : bu0;
                        const f32x2 sc2 = (f32x2){1.f / WGU_SCALE, 1.f / WGU_SCALE};
                        f32x2 g2 = __builtin_elementwise_fma((f32x2){ag[2 * hf], ag[2 * hf + 1]}, sc2, (f32x2){bg[2 * hf], bg[2 * hf + 1]});
                        f32x2 u2 = __builtin_elementwise_fma((f32x2){au[2 * hf], au[2 * hf + 1]}, sc2, (f32x2){bu[2 * hf], bu[2 * hf + 1]});
                        g2 = (f32x2){fminf(g2[0], 7.f), fminf(g2[1], 7.f)}; u2 = (f32x2){fminf(fmaxf(u2[0], -7.f), 7.f), fminf(fmaxf(u2[1], -7.f), 7.f)};
                        const f32x2 t2 = g2 * (f32x2){-1.702f * LOG2E, -1.702f * LOG2E};
                        const f32x2 d2 = (f32x2){ex2(t2[0]), ex2(t2[1])} + (f32x2){1.f, 1.f};
                        const f32x2 gs2 = g2 * (f32x2){__builtin_amdgcn_rcpf(d2[0]), __builtin_amdgcn_rcpf(d2[1])};
                        const f32x2 o2 = __builtin_elementwise_fma(u2, gs2, gs2);
                        o[n * 4 + 2 * hf] = o2[0]; o[n * 4 + 2 * hf + 1] = o2[1]; }
                wq[m].x = pk4_fp8(o[0], o[1], o[2], o[3]); wq[m].y = pk4_fp8(o[4], o[5], o[6], o[7]); (void)r; }
#pragma unroll
            for (int mp = 0; mp < 4; mp += 2) {
                const u32x2 sx = __builtin_amdgcn_permlane16_swap(wq[mp].x, wq[mp + 1].x, false, false), sy = __builtin_amdgcn_permlane16_swap(wq[mp].y, wq[mp + 1].y, false, false);
                const int r2 = ai * 128 + wr * 64 + (mp + (fq & 1)) * 16 + fr;
                *(u32x4*)(base + (size_t)r2 * 1024) = (u32x4){sx[0], sy[0], sx[1], sy[1]}; } }
    }
};
struct SchedDN {
    unsigned char* dout; unsigned char* ws; const char* W; MoeTab T; int G, c, NT;
    __device__ __forceinline__ bool next(int i, pg8::Unit& u) const {
        int tile, pn;
        if (G == 256) { const int x = c & 7, j = c >> 3; tile = i * 64 + x * 8 + (j >> 2); pn = j & 3; } else { const long L = (long)i * G + c; tile = (int)(L >> 2); pn = (int)(L & 3); }
        if (tile >= NT) return false;
        const int e = __builtin_amdgcn_readfirstlane((int)T.te[tile]);
        u.pm = tile; u.pn = pn; u.e = e; u.r0 = 0; return true;
    }
    const float* b_down;
    __device__ __forceinline__ const float* aux_src(const pg8::Unit& u, int tid) const { return b_down + u.e * DM + u.pn * 256 + tid; }
    __device__ __forceinline__ int lda_() const { return 1024; }
    __device__ __forceinline__ const char* a_base(const pg8::Unit& u) const { return (const char*)a_tile_ptr(dout, ws, u.pm); }
    __device__ __forceinline__ const char* b_base(const pg8::Unit& u) const { return W + ((size_t)u.e * 1024 + (size_t)u.pn * 256) * 1024; }
    __device__ __forceinline__ void a_offs(const pg8::Unit&, unsigned (&vo)[2][2], const int (&R)[2], const int (&C)[2]) const {
#pragma unroll
        for (int h = 0; h < 2; ++h)
#pragma unroll
            for (int i = 0; i < 2; ++i) vo[h][i] = (unsigned)((h * 128 + R[i]) * 1024 + C[i] * 2);
    }
};
struct EpiDN {
    static constexpr bool PERM = true, AFTER_DRAIN = false;
    LAS unsigned char* ldsb; unsigned char* ws;
    __device__ __forceinline__ void operator()(const acc_t& acc, const pg8::Unit& u, int wr, int wc, int fr, int fq) const {
        unsigned char* base = y_tile_ptr(ws, u.pm);
#pragma unroll
        for (int bj = 0; bj < 2; ++bj) { const int colw = u.pn * 256 + bj * 128 + wc * 32 + 8 * (fq & 2); const LAS float* ax = (const LAS float*)(ldsb + AUX_OFF) + u.slot * 256 + bj * 128 + wc * 32 + 8 * fq; const f32x4 b0 = *(const LAS f32x4*)(ax), b1 = *(const LAS f32x4*)(ax + 4);
#pragma unroll
            for (int ai = 0; ai < 2; ++ai)
#pragma unroll
                for (int mp = 0; mp < 4; mp += 2) { u32x2 w[2];
#pragma unroll
                    for (int k = 0; k < 2; ++k) { const f32x4 v0 = acc[ai][bj][mp + k][0] * (1.f / WDN_SCALE) + b0, v1 = acc[ai][bj][mp + k][1] * (1.f / WDN_SCALE) + b1; w[k].x = pk4_fp8(v0[0], v0[1], v0[2], v0[3]); w[k].y = pk4_fp8(v1[0], v1[1], v1[2], v1[3]); }
                    const u32x2 sx = __builtin_amdgcn_permlane16_swap(w[0].x, w[1].x, false, false), sy = __builtin_amdgcn_permlane16_swap(w[0].y, w[1].y, false, false);
                    const int r = ai * 128 + wr * 64 + (mp + (fq & 1)) * 16 + fr;
                    *(u32x4*)(base + (size_t)r * 1024 + colw) = (u32x4){sx[0], sy[0], sx[1], sy[1]}; } }
    }
};

namespace att {
__device__ __forceinline__ int crow(int r, int hh) { return (r & 3) + 8 * (r >> 2) + 4 * hh; }
__device__ __forceinline__ s16x4 vtr(const LAS unsigned char* p) { return __builtin_bit_cast(s16x4, __builtin_amdgcn_ds_read_tr16_b64_v4i16((LAS s16x4*)p)); }
#define MFMA32(a, b, c) __builtin_amdgcn_mfma_f32_32x32x16_bf16((a), (b), (c), 0, 0, 0)
constexpr float NEGB = -1.0e30f;

constexpr int MKB = 24576, MVB = 16384;
constexpr int M_KS = 0, M_VS = 3 * MKB, M_WSF = MISC_OFF + 2048;
constexpr float MLA_THR = 8.f;
__device__ __forceinline__ float max3f(float a, float b, float c) { return fmaxf(fmaxf(a, b), c); }
__device__ __forceinline__ void mla_qk(f32x16& p0, f32x16& p1, const LAS unsigned char* kb, const bf16x8 (&qf)[12]) {
#pragma unroll
    for (int d0 = 0; d0 < 12; ++d0) { const bf16x8 a0 = *(const LAS bf16x8*)(kb + d0 * 2048), a1 = *(const LAS bf16x8*)(kb + d0 * 2048 + 512); p0 = MFMA32(a0, qf[d0], p0); p1 = MFMA32(a1, qf[d0], p1); }
}
__device__ __forceinline__ void mla_mask(f32x16& p0, f32x16& p1, int t, int j, int qrel, int hh) {
    if (t == 0) {
#pragma unroll
        for (int r = 0; r < 16; ++r) { if (crow(r, hh) >= NMETA) p0[r] = NEGB; p1[r] = NEGB; }
    } else if (j >= 0) {
#pragma unroll
        for (int r = 0; r < 16; ++r) { const int kk = 64 * j + crow(r, hh); if (kk > qrel) p0[r] = NEGB; if (kk + 32 > qrel) p1[r] = NEGB; }
    }
}
__device__ __forceinline__ float mla_rowmax(const f32x16& p0, const f32x16& p1) {
    float a = max3f(p0[0], p0[1], p1[0]), c = max3f(p0[2], p0[3], p1[1]); a = max3f(a, p1[2], p1[3]);
#pragma unroll
    for (int r = 4; r < 16; r += 4) { a = max3f(a, p0[r], p0[r + 1]); c = max3f(c, p0[r + 2], p0[r + 3]); a = max3f(a, p1[r], p1[r + 1]); c = max3f(c, p1[r + 2], p1[r + 3]); }
    const float m = fmaxf(a, c);
    auto rr = __builtin_amdgcn_permlane32_swap(__float_as_uint(m), __float_as_uint(m), false, false);
    return fmaxf(__uint_as_float(rr[0]), __uint_as_float(rr[1]));
}
#define KLD(kb, d0, half) (*(const LAS bf16x8*)((kb) + (d0) * 2048 + (half) * 512))
#define VLD(vb, d0, ks, hi) vtr((vb) + (d0) * 4096 + (ks) * 1024 + (hi) * 512)
#define VPK(l, h) ((bf16x8){l[0], l[1], l[2], l[3], h[0], h[1], h[2], h[3]})
#define SBAR() __builtin_amdgcn_sched_barrier(0)
__device__ __forceinline__ void mla_step(f32x16 (&o)[4], float& l_run, float& mref, f32x16& nmv, const bf16x8 (&qf)[12], const LAS unsigned char* kb, const LAS unsigned char* vb, LAS float* wsf,
                                         int r32, int hh, int t, int j, int qrel) {
    f32x16 c0, c1;
    bf16x8 ka0 = KLD(kb, 0, 0), kb0f = KLD(kb, 0, 1), ka1 = KLD(kb, 1, 0), kb1f = KLD(kb, 1, 1);
    s16x4 vl0, vh0, vl1, vh1, vl2, vh2, vl3, vh3;
    c0 = MFMA32(ka0, qf[0], nmv); ka0 = KLD(kb, 2, 0); SBAR();
    c1 = MFMA32(kb0f, qf[0], nmv); kb0f = KLD(kb, 2, 1); SBAR();
    c0 = MFMA32(ka1, qf[1], c0); ka1 = KLD(kb, 3, 0); SBAR();
    c1 = MFMA32(kb1f, qf[1], c1); kb1f = KLD(kb, 3, 1); SBAR();
    c0 = MFMA32(ka0, qf[2], c0); ka0 = KLD(kb, 4, 0); SBAR();
    c1 = MFMA32(kb0f, qf[2], c1); kb0f = KLD(kb, 4, 1); SBAR();
    c0 = MFMA32(ka1, qf[3], c0); ka1 = KLD(kb, 5, 0); SBAR();
    c1 = MFMA32(kb1f, qf[3], c1); kb1f = KLD(kb, 5, 1); SBAR();
    c0 = MFMA32(ka0, qf[4], c0); ka0 = KLD(kb, 6, 0); SBAR();
    c1 = MFMA32(kb0f, qf[4], c1); kb0f = KLD(kb, 6, 1); SBAR();
    c0 = MFMA32(ka1, qf[5], c0); ka1 = KLD(kb, 7, 0); SBAR();
    c1 = MFMA32(kb1f, qf[5], c1); kb1f = KLD(kb, 7, 1); SBAR();
    c0 = MFMA32(ka0, qf[6], c0); ka0 = KLD(kb, 8, 0); SBAR();
    c1 = MFMA32(kb0f, qf[6], c1); kb0f = KLD(kb, 8, 1); SBAR();
    c0 = MFMA32(ka1, qf[7], c0); ka1 = KLD(kb, 9, 0); SBAR();
    c1 = MFMA32(kb1f, qf[7], c1); kb1f = KLD(kb, 9, 1); SBAR();
    c0 = MFMA32(ka0, qf[8], c0); ka0 = KLD(kb, 10, 0); SBAR();
    c1 = MFMA32(kb0f, qf[8], c1); kb0f = KLD(kb, 10, 1); SBAR();
    c0 = MFMA32(ka1, qf[9], c0); ka1 = KLD(kb, 11, 0); SBAR();
    c1 = MFMA32(kb1f, qf[9], c1); kb1f = KLD(kb, 11, 1); SBAR();
    c0 = MFMA32(ka0, qf[10], c0); vl0 = VLD(vb, 0, 0, 0); vh0 = VLD(vb, 0, 0, 1); SBAR();
    c1 = MFMA32(kb0f, qf[10], c1); vl1 = VLD(vb, 1, 0, 0); vh1 = VLD(vb, 1, 0, 1); SBAR();
    c0 = MFMA32(ka1, qf[11], c0); vl2 = VLD(vb, 2, 0, 0); vh2 = VLD(vb, 2, 0, 1); SBAR();
    c1 = MFMA32(kb1f, qf[11], c1); vl3 = VLD(vb, 3, 0, 0); vh3 = VLD(vb, 3, 0, 1); SBAR();
    mla_mask(c0, c1, t, j, qrel, hh);
    const float mx = mla_rowmax(c0, c1);
    if (__builtin_expect(t == 0 || __any(mx > MLA_THR), 0)) {
        const float dl = (t == 0) ? mx : fmaxf(mx, 0.f); const float alpha = (t == 0) ? 1.f : ex2(-dl);
        mref += dl; l_run *= alpha;
#pragma unroll
        for (int r = 0; r < 16; ++r) nmv[r] = -mref;
#pragma unroll
        for (int r = 0; r < 16; ++r) { c0[r] -= dl; c1[r] -= dl; }
        if (hh == 0) wsf[r32] = alpha;
#pragma unroll
        for (int r = 0; r < 16; ++r) { const float a = wsf[crow(r, hh)];
#pragma unroll
            for (int d = 0; d < 4; ++d) o[d][r] *= a; }
    }
    SBAR();
    float rs = 0.f; u32x4 pw0, pw1, pw2, pw3;
    c0[0] = ex2(c0[0]);
    c0[1] = ex2(c0[1]);
    c0[2] = ex2(c0[2]);
    c0[3] = ex2(c0[3]);
    c0[4] = ex2(c0[4]);
    c0[5] = ex2(c0[5]);
    c0[6] = ex2(c0[6]);
    c0[7] = ex2(c0[7]);
    c0[8] = ex2(c0[8]);
    c0[9] = ex2(c0[9]);
    c0[10] = ex2(c0[10]);
    c0[11] = ex2(c0[11]);
    c0[12] = ex2(c0[12]);
    c0[13] = ex2(c0[13]);
    c0[14] = ex2(c0[14]);
    c0[15] = ex2(c0[15]);
    rs += c0[0];
    rs += c0[1];
    rs += c0[2];
    rs += c0[3];
    rs += c0[4];
    rs += c0[5];
    rs += c0[6];
    rs += c0[7];
    rs += c0[8];
    rs += c0[9];
    rs += c0[10];
    rs += c0[11];
    rs += c0[12];
    rs += c0[13];
    rs += c0[14];
    rs += c0[15];
    pw0[0] = cvtpk(c0[0], c0[1]);
    pw0[1] = cvtpk(c0[2], c0[3]);
    pw0[2] = cvtpk(c0[4], c0[5]);
    pw0[3] = cvtpk(c0[6], c0[7]);
    pw1[0] = cvtpk(c0[8], c0[9]);
    pw1[1] = cvtpk(c0[10], c0[11]);
    pw1[2] = cvtpk(c0[12], c0[13]);
    pw1[3] = cvtpk(c0[14], c0[15]);
    SBAR();
    o[0] = MFMA32(__builtin_bit_cast(bf16x8, pw0), VPK(vl0, vh0), o[0]); vl0 = VLD(vb, 0, 1, 0); vh0 = VLD(vb, 0, 1, 1); c1[0] = ex2(c1[0]); c1[1] = ex2(c1[1]); SBAR();
    o[1] = MFMA32(__builtin_bit_cast(bf16x8, pw0), VPK(vl1, vh1), o[1]); vl1 = VLD(vb, 1, 1, 0); vh1 = VLD(vb, 1, 1, 1); c1[2] = ex2(c1[2]); c1[3] = ex2(c1[3]); rs += c1[0] + c1[1]; SBAR();
    o[2] = MFMA32(__builtin_bit_cast(bf16x8, pw0), VPK(vl2, vh2), o[2]); vl2 = VLD(vb, 2, 1, 0); vh2 = VLD(vb, 2, 1, 1); c1[4] = ex2(c1[4]); c1[5] = ex2(c1[5]); rs += c1[2] + c1[3]; SBAR();
    o[3] = MFMA32(__builtin_bit_cast(bf16x8, pw0), VPK(vl3, vh3), o[3]); vl3 = VLD(vb, 3, 1, 0); vh3 = VLD(vb, 3, 1, 1); c1[6] = ex2(c1[6]); c1[7] = ex2(c1[7]); rs += c1[4] + c1[5]; SBAR();
    o[0] = MFMA32(__builtin_bit_cast(bf16x8, pw1), VPK(vl0, vh0), o[0]); vl0 = VLD(vb, 0, 2, 0); vh0 = VLD(vb, 0, 2, 1); c1[8] = ex2(c1[8]); c1[9] = ex2(c1[9]); rs += c1[6] + c1[7]; pw2[0] = cvtpk(c1[0], c1[1]); pw2[1] = cvtpk(c1[2], c1[3]); SBAR();
    o[1] = MFMA32(__builtin_bit_cast(bf16x8, pw1), VPK(vl1, vh1), o[1]); vl1 = VLD(vb, 1, 2, 0); vh1 = VLD(vb, 1, 2, 1); c1[10] = ex2(c1[10]); c1[11] = ex2(c1[11]); rs += c1[8] + c1[9]; pw2[2] = cvtpk(c1[4], c1[5]); pw2[3] = cvtpk(c1[6], c1[7]); SBAR();
    o[2] = MFMA32(__builtin_bit_cast(bf16x8, pw1), VPK(vl2, vh2), o[2]); vl2 = VLD(vb, 2, 2, 0); vh2 = VLD(vb, 2, 2, 1); c1[12] = ex2(c1[12]); c1[13] = ex2(c1[13]); rs += c1[10] + c1[11]; SBAR();
    o[3] = MFMA32(__builtin_bit_cast(bf16x8, pw1), VPK(vl3, vh3), o[3]); vl3 = VLD(vb, 3, 2, 0); vh3 = VLD(vb, 3, 2, 1); c1[14] = ex2(c1[14]); c1[15] = ex2(c1[15]); rs += c1[12] + c1[13]; SBAR();
    o[0] = MFMA32(__builtin_bit_cast(bf16x8, pw2), VPK(vl0, vh0), o[0]); vl0 = VLD(vb, 0, 3, 0); vh0 = VLD(vb, 0, 3, 1); rs += c1[14] + c1[15]; pw3[0] = cvtpk(c1[8], c1[9]); pw3[1] = cvtpk(c1[10], c1[11]); SBAR();
    o[1] = MFMA32(__builtin_bit_cast(bf16x8, pw2), VPK(vl1, vh1), o[1]); vl1 = VLD(vb, 1, 3, 0); vh1 = VLD(vb, 1, 3, 1); pw3[2] = cvtpk(c1[12], c1[13]); pw3[3] = cvtpk(c1[14], c1[15]); SBAR();
    o[2] = MFMA32(__builtin_bit_cast(bf16x8, pw2), VPK(vl2, vh2), o[2]); vl2 = VLD(vb, 2, 3, 0); vh2 = VLD(vb, 2, 3, 1); SBAR();
    o[3] = MFMA32(__builtin_bit_cast(bf16x8, pw2), VPK(vl3, vh3), o[3]); vl3 = VLD(vb, 3, 3, 0); vh3 = VLD(vb, 3, 3, 1); SBAR();
    o[0] = MFMA32(__builtin_bit_cast(bf16x8, pw3), VPK(vl0, vh0), o[0]); SBAR();
    o[1] = MFMA32(__builtin_bit_cast(bf16x8, pw3), VPK(vl1, vh1), o[1]); SBAR();
    o[2] = MFMA32(__builtin_bit_cast(bf16x8, pw3), VPK(vl2, vh2), o[2]); SBAR();
    o[3] = MFMA32(__builtin_bit_cast(bf16x8, pw3), VPK(vl3, vh3), o[3]); SBAR();
    l_run += rs;
}
__device__ __forceinline__ void mla_unit(int b, int h, int qb, const bf16_t* __restrict__ Q, const bf16_t* __restrict__ K, const bf16_t* __restrict__ V, bf16_t* __restrict__ O, float* __restrict__ SSQO, const float* __restrict__ SSQQ, const float* __restrict__ ROPE, LAS unsigned char* lds, int tid_) {
    asm volatile("" : "+v"(tid_));
    const int tid = tid_, lane = tid & 63, r32 = lane & 31, hh = lane >> 5; const int wid = __builtin_amdgcn_readfirstlane(tid >> 6);
    const int NT = 4 * qb + 5;
    LAS float* wsf = (LAS float*)(lds + M_WSF) + wid * 64;
    const unsigned lds0 = (unsigned)__builtin_amdgcn_readfirstlane((int)(unsigned)(unsigned long)lds);
    const unsigned voffK = (unsigned)lane * 1536u, voffV = (unsigned)(lane >> 2) * 1024u + (unsigned)(lane & 3) * 16u;
    const char* Kh = (const char*)K + h * 384 + wid * 16; const char* Vh = (const char*)V + h * 256 + (wid >> 2) * 64 + (size_t)(wid & 3) * 16 * 1024;
#define MLA_ROW0(t) ((t) == 0 ? (size_t)MX : (size_t)(b * SEQ + ((t) - 1) * 64))
#define MLA_DMA_K(t, slot) do { const char* kp = Kh + MLA_ROW0(t) * 1536; const unsigned kd = lds0 + M_KS + (slot) * MKB + wid * 1024; \
        pg8::glds16(kp, voffK, kd); pg8::glds16(kp + 128, voffK, kd + 8192); pg8::glds16(kp + 256, voffK, kd + 16384); } while (0)
#define MLA_DMA_V(t, slot) do { const char* vp = Vh + MLA_ROW0(t) * 1024; const unsigned vd = lds0 + M_VS + (slot) * MVB + wid * 1024; \
        pg8::glds16(vp, voffV, vd); pg8::glds16(vp + 128, voffV, vd + 8192); } while (0)
    MLA_DMA_K(0, 0); MLA_DMA_V(0, 0); MLA_DMA_K(1, 1); MLA_DMA_V(1, 1);
    bf16x8 qf[12];
    { const int xrow = qb * 256 + wid * 32 + r32; const size_t grow = (size_t)b * SEQ + xrow;
      const bf16_t* qrow = Q + grow * 768 + h * 192 + hh * 8;
#pragma unroll
      for (int d0 = 0; d0 < 12; ++d0) qf[d0] = *(const bf16x8*)(qrow + d0 * 16);
      const f32x4 sq = *(const f32x4*)(SSQQ + grow * 4); const float rsq = QSCALE / sqrtf(((sq[0] + sq[1]) + (sq[2] + sq[3])) * (1.f / 256.f) + RMS_EPS);
      const float* rp = ROPE + ((size_t)(NMETA + xrow) * 32 + hh * 4) * 2;
#pragma unroll
      for (int d0 = 0; d0 < 12; ++d0) { const u32x4 w = __builtin_bit_cast(u32x4, qf[d0]);
          f32x4 a = (f32x4){bf_lo(w[0]), bf_hi(w[0]), bf_lo(w[1]), bf_hi(w[1])}, c = (f32x4){bf_lo(w[2]), bf_hi(w[2]), bf_lo(w[3]), bf_hi(w[3])};
          if (d0 >= 8) { const f32x4 cs0 = *(const f32x4*)(rp + (d0 - 8) * 16), cs1 = *(const f32x4*)(rp + (d0 - 8) * 16 + 4); rope8(a, c, cs0, cs1); }
          qf[d0] = __builtin_bit_cast(bf16x8, pack8(a, c, rsq)); }
#pragma unroll
      for (int d0 = 0; d0 < 12; ++d0) asm volatile("" : "+v"(qf[d0])); }
    f32x16 o[4];
#pragma unroll
    for (int d = 0; d < 4; ++d)
#pragma unroll
        for (int r = 0; r < 16; ++r) o[d][r] = 0.f;
    f32x16 nmv;
#pragma unroll
    for (int r = 0; r < 16; ++r) nmv[r] = -0.f;
    float mref = 0.f, l_run = 0.f;
    const int qrel = wid * 32 + r32;
    const int vboff = ((lane >> 4) & 1) * 32 + (lane & 3) * 8 + (4 * hh + ((lane & 15) >> 2)) * 64;
    const LAS unsigned char* kb0 = lds + M_KS + hh * 1024 + r32 * 16;
    asm volatile("s_waitcnt vmcnt(0)" ::: "memory"); __syncthreads();
    int sc = 0, sn = 2;
#pragma unroll 1
    for (int t = 0; t < NT; ++t) {
        const bool more = t + 2 < NT;
        if (more) { MLA_DMA_K(t + 2, sn); MLA_DMA_V(t + 2, sn); }
        const int j = t - (NT - 4);
        if (j <= (wid >> 1)) mla_step(o, l_run, mref, nmv, qf, kb0 + sc * MKB, lds + M_VS + sc * MVB + vboff, wsf, r32, hh, t, j, qrel);
        if (more) asm volatile("s_waitcnt vmcnt(5)" ::: "memory"); else asm volatile("s_waitcnt vmcnt(0)" ::: "memory");
        __syncthreads();
        sn = sc; sc = (sc == 2) ? 0 : sc + 1;
    }
    { float lt = l_run + __shfl_xor(l_run, 32); const float inv = 1.f / lt;
      if (hh == 0) wsf[32 + r32] = inv;
      LAS unsigned char* tw = lds + wid * 8704;
#pragma unroll
      for (int r = 0; r < 16; ++r) { const int q = crow(r, hh); const float a = wsf[32 + q];
#pragma unroll
          for (int d = 0; d < 4; ++d) *(LAS bf16_t*)(tw + q * 272 + (d * 32 + r32) * 2) = (bf16_t)(cvtpk(o[d][r] * a, 0.f) & 0xffffu); }
      asm volatile("s_waitcnt lgkmcnt(0)" ::: "memory");
      const int c16 = lane & 15, rq = lane >> 4;
      bf16_t* obase = O + (size_t)(b * SEQ + qb * 256 + wid * 32) * 1024 + h * 128 + c16 * 8;
#pragma unroll
      for (int i = 0; i < 8; ++i) { const int row = 4 * i + rq; const u32x4 w = *(const LAS u32x4*)(tw + row * 272 + c16 * 16);
          *(u32x4*)(obase + (size_t)row * 1024) = w;
          float sq = 0.f;
#pragma unroll
          for (int k = 0; k < 4; ++k) { const float lo = bf_lo(w[k]), hi = bf_hi(w[k]); sq += lo * lo + hi * hi; }
#pragma unroll
          for (int x = 1; x < 16; x <<= 1) sq += __shfl_xor(sq, x);
          if (c16 == 0) SSQO[(size_t)(b * SEQ + qb * 256 + wid * 32 + row) * 16 + h] = sq; } }
    asm volatile("s_waitcnt vmcnt(0)" ::: "memory"); __syncthreads();
#undef MLA_ROW0
#undef MLA_DMA_K
#undef MLA_DMA_V
}
#undef KLD
#undef VLD
#undef VPK
#undef SBAR

constexpr int SKB = 8192, SVB = 8192, SBUF = SKB + SVB;
constexpr int S_FLAG = 3 * SBUF;
constexpr float SB_STOP = 1.0e-43f;
template <bool MASKED>
__device__ __forceinline__ void sb_half(f32x16& P, int H, int t, int j, int qrel, int hh, float& carry) {
    float kp[16];
#pragma unroll
    for (int r = 0; r < 16; ++r) { const float E = ex2(fminf(P[r], 80.f)); const float k = __builtin_amdgcn_rcpf(1.f + E); float bt = E * k; float kk = k;
        if (MASKED) { const int key = 32 * H + crow(r, hh); const bool valid = (t == 0) ? (key < NMETA) : ((64 * j + key) < qrel); bt = valid ? bt : 0.f; kk = valid ? k : 1.f; }
        P[r] = bt; kp[r] = kk; }
    float e[16], a[4], bs[4];
#pragma unroll
    for (int g = 0; g < 4; ++g) { e[4 * g + 3] = 1.f; e[4 * g + 2] = kp[4 * g + 3]; e[4 * g + 1] = e[4 * g + 2] * kp[4 * g + 2]; e[4 * g] = e[4 * g + 1] * kp[4 * g + 1]; a[g] = e[4 * g] * kp[4 * g]; bs[g] = __shfl_xor(a[g], 32); }
    const float a3 = a[3], a23 = a[2] * a3, a123 = a[1] * a23, a0123 = a[0] * a123;
    const float b3 = bs[3], b23 = bs[2] * b3, b123 = bs[1] * b23, b0123 = bs[0] * b123;
    float SG[4];
    SG[3] = hh ? 1.f : b3; SG[2] = a3 * (hh ? b3 : b23); SG[1] = a23 * (hh ? b23 : b123); SG[0] = a123 * (hh ? b123 : b0123);
#pragma unroll
    for (int g = 0; g < 4; ++g) { const float cg = carry * SG[g];
#pragma unroll
        for (int i = 0; i < 4; ++i) P[4 * g + i] = P[4 * g + i] * (cg * e[4 * g + i]); }
    carry *= (a0123 * b0123);
}
__device__ __forceinline__ void sb_unit(int b, int h, int qb, const bf16_t* __restrict__ Q, const bf16_t* __restrict__ K, const bf16_t* __restrict__ V, bf16_t* __restrict__ O, float* __restrict__ SSQO, LAS unsigned char* lds, int tid_) {
    asm volatile("" : "+v"(tid_));
    const int tid = tid_, lane = tid & 63, r32 = lane & 31, hh = lane >> 5; const int wid = __builtin_amdgcn_readfirstlane(tid >> 6);
    const int NT = 4 * qb + 5;
    bf16x8 qf[4];
    { const bf16_t* qrow = Q + (size_t)(b * SEQ + qb * 256 + wid * 32 + r32) * 512 + h * 64 + hh * 8;
#pragma unroll
      for (int d0 = 0; d0 < 4; ++d0) qf[d0] = *(const bf16x8*)(qrow + d0 * 16); }
    LAS unsigned* flags = (LAS unsigned*)(lds + S_FLAG);
    u32x4 kreg, vreg, kreg2, vreg2;
    const int vkey = ((tid >> 6) & 3) * 16 + ((tid >> 2) & 15), vd = (tid >> 8) * 32 + (tid & 3) * 8;
#define SB_ROW(t, key) ((t) == 0 ? (size_t)(MX + (key)) : (size_t)(b * SEQ + ((t) - 1) * 64 + (key)))
#define SB_LOAD(t) do { kreg = *(const u32x4*)(K + SB_ROW(t, lane) * 512 + h * 64 + wid * 8); vreg = *(const u32x4*)(V + SB_ROW(t, vkey) * 512 + h * 64 + vd); } while (0)
#define SB_LOAD2(t) do { kreg2 = *(const u32x4*)(K + SB_ROW(t, lane) * 512 + h * 64 + wid * 8); vreg2 = *(const u32x4*)(V + SB_ROW(t, vkey) * 512 + h * 64 + vd); } while (0)
#define SB_STORE2(buf) do { LAS unsigned char* bb = lds + (buf) * SBUF; *(LAS u32x4*)(bb + wid * 1024 + lane * 16) = kreg2; *(LAS u32x4*)(bb + SKB + tid * 16) = vreg2; } while (0)
#define SB_STORE(buf) do { LAS unsigned char* bb = lds + (buf) * SBUF; *(LAS u32x4*)(bb + wid * 1024 + lane * 16) = kreg; *(LAS u32x4*)(bb + SKB + tid * 16) = vreg; } while (0)
    SB_LOAD(NT - 1); SB_STORE(0); __syncthreads();
    SB_LOAD(NT - 2);
    f32x16 o[2];
#pragma unroll
    for (int d = 0; d < 2; ++d)
#pragma unroll
        for (int r = 0; r < 16; ++r) o[d][r] = 0.f;
    float carry = 1.f; bool wdone = false;
    const int qrel = wid * 32 + r32;
    const int vboff = ((lane >> 4) & 1) * 32 + (lane & 3) * 8 + (4 * hh + ((lane & 15) >> 2)) * 64;
    const bool stag = wid >= 4;
    f32x16 p0, p1; bool pend = false; int tp = 0, jp = 0, bufp = 0;
    auto mathpv = [&](int t_, int j_, int vbuf) {
        if (t_ == 0 || j_ >= 0) { sb_half<true>(p1, 1, t_, j_, qrel, hh, carry); sb_half<true>(p0, 0, t_, j_, qrel, hh, carry); }
        else { sb_half<false>(p1, 1, t_, j_, qrel, hh, carry); sb_half<false>(p0, 0, t_, j_, qrel, hh, carry); }
        u32x4 pw[4];
#pragma unroll
        for (int i = 0; i < 4; ++i) { pw[0][i] = cvtpk(p0[2 * i], p0[2 * i + 1]); pw[1][i] = cvtpk(p0[8 + 2 * i], p0[8 + 2 * i + 1]); pw[2][i] = cvtpk(p1[2 * i], p1[2 * i + 1]); pw[3][i] = cvtpk(p1[8 + 2 * i], p1[8 + 2 * i + 1]); }
        const LAS unsigned char* vb = lds + vbuf * SBUF + SKB + vboff;
#pragma unroll
        for (int d0 = 0; d0 < 2; ++d0)
#pragma unroll
            for (int ks = 0; ks < 4; ++ks) { const s16x4 lo = vtr(vb + d0 * 4096 + ks * 1024), hi = vtr(vb + d0 * 4096 + ks * 1024 + 512);
                const bf16x8 vf = (bf16x8){lo[0], lo[1], lo[2], lo[3], hi[0], hi[1], hi[2], hi[3]};
                o[d0] = MFMA32(__builtin_bit_cast(bf16x8, pw[ks]), vf, o[d0]); }
        wdone = __all(carry < SB_STOP);
    };
    int it = 0, buf = 0;
    auto body = [&](int t, auto SEL) -> bool {
        const int nbuf = buf == 2 ? 0 : buf + 1;
        if (t > 1) { if constexpr (decltype(SEL)::value == 0) SB_LOAD2(t - 2); else SB_LOAD(t - 2); }
        const int j = t - (NT - 4);
        if (stag && pend) { mathpv(tp, jp, bufp); pend = false; }
        if (!wdone && j <= (wid >> 1)) {
            const LAS unsigned char* kb = lds + buf * SBUF + hh * 1024 + r32 * 16;
#pragma unroll
            for (int r = 0; r < 16; ++r) { p0[r] = 0.f; p1[r] = 0.f; }
#pragma unroll
            for (int d0 = 0; d0 < 4; ++d0) { const bf16x8 a0 = *(const LAS bf16x8*)(kb + d0 * 2048), a1 = *(const LAS bf16x8*)(kb + d0 * 2048 + 512); p0 = MFMA32(a0, qf[d0], p0); p1 = MFMA32(a1, qf[d0], p1); }
            if (!stag) mathpv(t, j, buf); else { pend = true; tp = t; jp = j; bufp = buf; }
        }
        if (lane == 0) flags[(it & 1) * 8 + wid] = wdone ? 1u : 0u;
        if (t > 0) { if constexpr (decltype(SEL)::value == 0) SB_STORE(nbuf); else SB_STORE2(nbuf); }
        __syncthreads();
        unsigned alld = 1u;
#pragma unroll
        for (int w = 0; w < 8; ++w) alld &= flags[(it & 1) * 8 + w];
        buf = nbuf; ++it;
        return alld != 0u;
    };
    for (int t = NT - 1; t >= 0; t -= 2) {
        if (body(t, std::integral_constant<int, 0>{})) break;
        if (t - 1 < 0) break;
        if (body(t - 1, std::integral_constant<int, 1>{})) break;
    }
    if (pend) mathpv(tp, jp, bufp);
    __syncthreads();
    {
      LAS unsigned char* tw = lds + wid * 4608;
#pragma unroll
      for (int r = 0; r < 16; ++r) { const int q = crow(r, hh);
#pragma unroll
          for (int d = 0; d < 2; ++d) *(LAS bf16_t*)(tw + q * 144 + (d * 32 + r32) * 2) = (bf16_t)(cvtpk(o[d][r], 0.f) & 0xffffu); }
      asm volatile("s_waitcnt lgkmcnt(0)" ::: "memory");
      const int c8 = lane & 7, rq = lane >> 3;
      bf16_t* obase = O + (size_t)(b * SEQ + qb * 256 + wid * 32) * 1024 + 512 + h * 64 + c8 * 8;
#pragma unroll
      for (int i = 0; i < 4; ++i) { const int row = 8 * i + rq; const u32x4 w = *(const LAS u32x4*)(tw + row * 144 + c8 * 16);
          *(u32x4*)(obase + (size_t)row * 1024) = w;
          float sq = 0.f;
#pragma unroll
          for (int k = 0; k < 4; ++k) { const float lo = bf_lo(w[k]), hi = bf_hi(w[k]); sq += lo * lo + hi * hi; }
#pragma unroll
          for (int x = 1; x < 8; x <<= 1) sq += __shfl_xor(sq, x);
          if (c8 == 0) SSQO[(size_t)(b * SEQ + qb * 256 + wid * 32 + row) * 16 + 4 + h] = sq; } }
    __syncthreads();
#undef SB_ROW
#undef SB_LOAD
#undef SB_LOAD2
#undef SB_STORE2
#undef SB_STORE
}
}

#define XB_TMO      128
#define XB_XCNT(j)  (256  + 64 * (j))
#define XB_XSUB(j)  (1280 + 64 * (j))
#define XB_XGEN(j)  (2304 + 64 * (j))
#define XB_TOP      3328
#define XB_TOPGEN   3392
#define XCD_BAR_WORDS 3456
#define XB_SPIN_CAP (1u << 18)
__device__ __forceinline__ unsigned xb_ld(unsigned* p)              { return __hip_atomic_load(p, __ATOMIC_RELAXED, __HIP_MEMORY_SCOPE_AGENT); }
__device__ __forceinline__ unsigned xb_add(unsigned* p, unsigned v) { return __hip_atomic_fetch_add(p, v, __ATOMIC_RELAXED, __HIP_MEMORY_SCOPE_AGENT); }
__device__ __forceinline__ unsigned xb_xcc_id() { return (unsigned)__builtin_amdgcn_s_getreg((3 << 11) | 20) & 0xFu; }
#define XB_SPIN(cond, bar) do { unsigned _sp = 0; while (cond) { __builtin_amdgcn_s_sleep(1); \
    if ((++_sp & 255u) == 0u) { if (xb_ld(&(bar)[XB_TMO])) break; if (_sp > XB_SPIN_CAP) { atomicAdd(&(bar)[XB_TMO], 1u); break; } } } } while (0)
struct XcdBarrier { unsigned* bar; unsigned x; volatile LAS unsigned* st; };
__device__ __forceinline__ XcdBarrier xcd_barrier_post(unsigned* bar, volatile LAS unsigned* st, bool leader) {
    XcdBarrier b; b.bar = bar; b.x = xb_xcc_id(); b.st = st;
    if (leader) (void)xb_add(&bar[XB_XCNT(b.x)], 1u);
    return b;
}
__device__ __forceinline__ void xcd_barrier_complete(unsigned* bar, unsigned x, unsigned& nloc, unsigned& nx) {
    const unsigned G = gridDim.x * gridDim.y * gridDim.z;
    unsigned sum, cnt, mine, sp = 0u;
    for (;;) {
        sum = 0u; cnt = 0u; mine = 0u;
#pragma unroll
        for (unsigned j = 0; j < 16; ++j) { const unsigned c = xb_ld(&bar[XB_XCNT(j)]); sum += c; cnt += (c > 0u) ? 1u : 0u; mine = (j == x) ? c : mine; }
        if (sum == G) break;
        __builtin_amdgcn_s_sleep(1);
        if ((++sp & 255u) == 0u) { if (xb_ld(&bar[XB_TMO])) break; if (sp > XB_SPIN_CAP) { atomicAdd(&bar[XB_TMO], 1u); break; } }
    }
    nloc = mine > 0u ? mine : 1u; nx = cnt > 0u ? cnt : 1u;
}
__device__ __forceinline__ void xcd_barrier(const XcdBarrier& b, bool leader) {
    asm volatile("s_waitcnt vmcnt(0)" ::: "memory");
    __syncthreads();
    if (leader) {
        unsigned* bar = b.bar;
        __builtin_amdgcn_s_waitcnt(0);
        unsigned nloc = b.st[0], nx = b.st[1];
        if (nloc == 0u) { xcd_barrier_complete(bar, b.x, nloc, nx); b.st[0] = nloc; b.st[1] = nx; }
        const unsigned old = xb_add(&bar[XB_XSUB(b.x)], 1u);
        const unsigned gen = old / nloc;
        if (old + 1u == (gen + 1u) * nloc) {
            __builtin_amdgcn_fence(__ATOMIC_RELEASE, "agent");
            asm volatile("s_waitcnt vmcnt(0)" ::: "memory");
            const unsigned og = xb_add(&bar[XB_TOP], 1u);
            const unsigned tg = og / nx;
            if (og + 1u == (tg + 1u) * nx) xb_add(&bar[XB_TOPGEN], 1u);
            else XB_SPIN(xb_ld(&bar[XB_TOPGEN]) == tg, bar);
            __builtin_amdgcn_fence(__ATOMIC_ACQUIRE, "agent");
            xb_add(&bar[XB_XGEN(b.x)], 1u);
            asm volatile("s_waitcnt vmcnt(0)" ::: "memory");
        } else {
            XB_SPIN(xb_ld(&bar[XB_XGEN(b.x)]) == gen, bar);
            __builtin_amdgcn_fence(__ATOMIC_ACQUIRE, "agent");
            asm volatile("s_waitcnt vmcnt(0)" ::: "memory");
        }
    }
    __syncthreads();
}

template <class ColMap>
__device__ __forceinline__ void transpose_item(const float* __restrict__ W, int K, int Nsrc, bf16_t* __restrict__ WT, LAS float* scr, int kb, int n0, int lane, const float* __restrict__ kscale, ColMap cm) {
    const int k0 = 64 * kb; const int sc = cm(n0 + (lane & 31));
#pragma unroll 1
    for (int ib = 0; ib < 32; ib += 8) {
        const int scc = sc >= 0 ? sc : 0; float v[8], ks[8];
#pragma unroll
        for (int i = 0; i < 8; ++i) { const int kk = 2 * (ib + i) + (lane >> 5); v[i] = W[(size_t)(k0 + kk) * Nsrc + scc]; ks[i] = kscale ? kscale[k0 + kk] : 1.f; }
#pragma unroll
        for (int i = 0; i < 8; ++i) { const int kk = 2 * (ib + i) + (lane >> 5); scr[kk * 33 + (lane & 31)] = sc >= 0 ? v[i] * ks[i] : 0.f; } }
    asm volatile("s_waitcnt lgkmcnt(0)" ::: "memory");
    const int c = lane & 7;
#pragma unroll
    for (int j = 0; j < 4; ++j) { const int n = (lane >> 3) + 8 * j; const LAS float* s = scr + (8 * c) * 33 + n;
        u32x4 o; o.x = cvtpk(s[0 * 33], s[1 * 33]); o.y = cvtpk(s[2 * 33], s[3 * 33]); o.z = cvtpk(s[4 * 33], s[5 * 33]); o.w = cvtpk(s[6 * 33], s[7 * 33]);
        *(u32x4*)(WT + (size_t)(n0 + n) * K + k0 + 8 * c) = o; }
    asm volatile("s_waitcnt lgkmcnt(0)" ::: "memory");
}
__device__ __forceinline__ void sincos_acc(float ang, float& c, float& s) {
    const double x = (double)ang; const double n = rint(x * 0.6366197723675814); const double r = (x - n * 1.5707963267341256) - n * 6.077100506506192e-11;
    const double r2 = r * r;
    double sp = r * (1.0 + r2 * (-1.0 / 6 + r2 * (1.0 / 120 + r2 * (-1.0 / 5040 + r2 * (1.0 / 362880 + r2 * (-1.0 / 39916800 + r2 * (1.0 / 6227020800.0)))))));
    double cp = 1.0 + r2 * (-0.5 + r2 * (1.0 / 24 + r2 * (-1.0 / 720 + r2 * (1.0 / 40320 + r2 * (-1.0 / 3628800 + r2 * (1.0 / 479001600.0 + r2 * (-1.0 / 87178291200.0)))))));
    const int q = ((int)n) & 3;
    const double ss = (q == 0) ? sp : (q == 1) ? cp : (q == 2) ? -sp : -cp;
    const double cc = (q == 0) ? cp : (q == 1) ? -sp : (q == 2) ? -cp : sp;
    c = (float)cc; s = (float)ss;
}

template <int NSTEP>
__device__ __forceinline__ f32x4 meta_tile(const bf16_t* A, int lda, const bf16_t* Bt, int K, int lane, int wave, LAS unsigned char* lds) {
    const bf16_t* ap = A + (size_t)(lane & 15) * lda + 8 * (lane >> 4) + wave * (32 * NSTEP); const bf16_t* bp = Bt + (size_t)(lane & 15) * K + 8 * (lane >> 4) + wave * (32 * NSTEP);
    bf16x8 a[NSTEP], b[NSTEP];
#pragma unroll
    for (int i = 0; i < NSTEP; ++i) { a[i] = *(const bf16x8*)(ap + 32 * i); b[i] = *(const bf16x8*)(bp + 32 * i); }
    f32x4 acc = (f32x4){0.f, 0.f, 0.f, 0.f};
#pragma unroll
    for (int i = 0; i < NSTEP; ++i) acc = __builtin_amdgcn_mfma_f32_16x16x32_bf16(a[i], b[i], acc, 0, 0, 0);
    LAS f32x4* red = (LAS f32x4*)lds;
    __syncthreads(); red[wave * 64 + lane] = acc; __syncthreads();
    if (wave == 0) {
#pragma unroll
        for (int w = 1; w < 8; ++w) acc += red[w * 64 + lane]; }
    return acc;
}
__device__ __forceinline__ bf16_t bf1(float v) { return (bf16_t)(cvtpk(v, 0.f) & 0xffffu); }
__device__ __forceinline__ void meta_inproj(unsigned char* ws, int task, int lane, int wave, LAS unsigned char* lds) {
    const int n0 = task < 16 ? 256 + 16 * task : (task < 48 ? 1024 + 16 * (task - 16) : (task < 80 ? 1536 + 16 * (task - 48) : 2048 + 16 * (task - 80)));
    const bf16_t* HB = (const bf16_t*)(ws + WS_HB) + (size_t)MX * 1024; const bf16_t* W = (const bf16_t*)(ws + WS_WIN) + (size_t)n0 * 1024;
    const f32x4 acc = meta_tile<4>(HB, 1024, W, 1024, lane, wave, lds);
    if (wave != 0) return;
    const int col = lane & 15, rq = lane >> 4;
#pragma unroll
    for (int jj = 0; jj < 4; ++jj) { const int row = 4 * rq + jj; const float v = acc[jj];
        if (task < 16) { ((bf16_t*)(ws + R_CKV))[(size_t)(MX + row) * 256 + (n0 - 256) + col] = bf1(v); ((float*)(ws + WS_METAF))[row * 256 + (n0 - 256) + col] = v; }
        else if (task < 48) ((bf16_t*)(ws + R_SBK))[(size_t)(MX + row) * 512 + (n0 - 1024) + col] = bf1(v);
        else if (task < 80) ((bf16_t*)(ws + R_SBV))[(size_t)(MX + row) * 512 + (n0 - 1536) + col] = bf1(v);
        else { const int c = n0 - 2048 + col; const float pv = __shfl_xor(v, 1); const float x1 = (c & 1) ? pv : v, x2 = (c & 1) ? v : pv;
            const float* cs = (const float*)(ws + WS_ROPE) + ((size_t)row * 32 + (c >> 1)) * 2; const float o = (c & 1) ? x2 * cs[0] + x1 * cs[1] : x1 * cs[0] - x2 * cs[1]; const bf16_t ob = bf1(o);
#pragma unroll
            for (int h = 0; h < 4; ++h) ((bf16_t*)(ws + R_K))[(size_t)(MX + row) * 768 + h * 192 + 128 + c] = ob; } }
}
__device__ __forceinline__ void meta_kvup(unsigned char* ws, int task, int lane, int wave, LAS unsigned char* lds) {
    const float* mf = (const float*)(ws + WS_METAF) + (lane & 15) * 256 + (lane >> 4) * 64; float ss = 0.f;
#pragma unroll
    for (int i = 0; i < 16; ++i) { const f32x4 f = *(const f32x4*)(mf + 4 * i); ss += (f[0] * f[0] + f[1] * f[1]) + (f[2] * f[2] + f[3] * f[3]); }
    ss += __shfl_xor(ss, 16); ss += __shfl_xor(ss, 32);
    const float rs_row = 1.f / sqrtf(ss * (1.f / 256.f) + RMS_EPS);
    const int n0 = 16 * task;
    const f32x4 acc = meta_tile<1>((const bf16_t*)(ws + R_CKV) + (size_t)MX * 256, 256, (const bf16_t*)(ws + WS_WUKV) + (size_t)n0 * 256, 256, lane, wave, lds);
    if (wave != 0) return;
    const int n = n0 + (lane & 15), rq = lane >> 4;
#pragma unroll
    for (int jj = 0; jj < 4; ++jj) { const int row = 4 * rq + jj; const float rs = __shfl(rs_row, row); const bf16_t ob = bf1(acc[jj] * rs);
        if (n < 512) ((bf16_t*)(ws + R_K))[(size_t)(MX + row) * 768 + (n >> 7) * 192 + (n & 127)] = ob; else ((bf16_t*)(ws + R_V))[(size_t)(MX + row) * 512 + (n - 512)] = ob; }
}

constexpr int CV_NI_GU = NE * 16 * 64, CV_NI = CV_NI_GU + NE * 16 * 32;
__device__ __forceinline__ void convert_experts(const float* __restrict__ WG, const float* __restrict__ WU, const float* __restrict__ WD, unsigned char* ws, LAS float* scr, int lane, int first, int step, int n) {
    const int kk = lane >> 3, nq = lane & 7;
    auto src_of = [&](int it) -> const float* {
        if (it < CV_NI_GU) { const int e = it / 1024, r = it % 1024, kb = r / 64, nb = r % 64; const int half = (nb >> 2) & 1; const int n0 = nb * 32;
            return (half ? WU : WG) + (size_t)e * 1024 * 1024 + (size_t)(64 * kb + kk) * 1024 + ((n0 >> 8) * 128 + (n0 & 127)) + 4 * nq; }
        const int i2 = it - CV_NI_GU; const int e = i2 / 512, r = i2 % 512, kb = r / 32, nb = r % 32;
        return WD + (size_t)e * 1024 * 1024 + (size_t)(64 * kb + kk) * 1024 + nb * 32 + 4 * nq; };
    f32x4 cur[8], nxt[8];
    int it = first;
    if (n > 0) { const float* p = src_of(it);
#pragma unroll
        for (int i = 0; i < 8; ++i) cur[i] = __builtin_nontemporal_load((const f32x4*)(p + (size_t)i * 8 * 1024)); }
#pragma unroll 1
    for (int c_ = 0; c_ < n; ++c_, it += step) {
        if (c_ + 1 < n) { const float* p = src_of(it + step);
#pragma unroll
            for (int i = 0; i < 8; ++i) nxt[i] = __builtin_nontemporal_load((const f32x4*)(p + (size_t)i * 8 * 1024)); }
#pragma unroll
        for (int i = 0; i < 8; ++i) { LAS float* d = scr + (8 * i + kk) * 33 + 4 * nq; d[0] = cur[i][0]; d[1] = cur[i][1]; d[2] = cur[i][2]; d[3] = cur[i][3]; }
        asm volatile("s_waitcnt lgkmcnt(0)" ::: "memory");
        unsigned char* wt; int kb, n0; float sc;
        if (it < CV_NI_GU) { const int e = it / 1024, r = it % 1024; kb = r / 64; n0 = (r % 64) * 32; wt = ws + WS_WGU + (size_t)e * 2048 * 1024; sc = WGU_SCALE; }
        else { const int i2 = it - CV_NI_GU; const int e = i2 / 512, r = i2 % 512; kb = r / 32; n0 = (r % 32) * 32; wt = ws + WS_WDN + (size_t)e * 1024 * 1024; sc = WDN_SCALE; }
        const int c = lane & 7;
#pragma unroll
        for (int j = 0; j < 4; ++j) { const int nn = (lane >> 3) + 8 * j; const LAS float* sp = scr + (8 * c) * 33 + nn;
            u32x2 o; o.x = pk4_fp8(sp[0 * 33] * sc, sp[1 * 33] * sc, sp[2 * 33] * sc, sp[3 * 33] * sc); o.y = pk4_fp8(sp[4 * 33] * sc, sp[5 * 33] * sc, sp[6 * 33] * sc, sp[7 * 33] * sc);
            __builtin_nontemporal_store(o, (u32x2*)(wt + (size_t)(n0 + nn) * 1024 + 64 * kb + 8 * c)); }
        asm volatile("s_waitcnt lgkmcnt(0)" ::: "memory");
#pragma unroll
        for (int i = 0; i < 8; ++i) cur[i] = nxt[i];
    }
}

struct Args { const float* in[22]; float* out; unsigned char* ws; float freq[32]; };
enum { I_X = 0, I_META, I_WIN, I_QG, I_WUQ, I_KVG, I_WUKV, I_MLAG, I_SBG, I_WO, I_LN1G, I_LN1B, I_WR, I_BR, I_WG, I_BG, I_WU, I_BU, I_WD, I_BD, I_LN2G, I_LN2B };

__global__ void __launch_bounds__(512, 2) fwd(Args args) {
    extern __shared__ __attribute__((aligned(16))) unsigned char lds_raw[];
    LAS unsigned char* lds = (LAS unsigned char*)lds_raw;
    volatile LAS unsigned* MISC = (volatile LAS unsigned*)(lds + MISC_OFF);
    const int G = gridDim.x, bx = blockIdx.x;
    const int wave_s = __builtin_amdgcn_readfirstlane((int)threadIdx.x >> 6);
#define LANE_ID() ([]() { int l_; asm volatile("v_mbcnt_lo_u32_b32 %0, -1, 0\n\tv_mbcnt_hi_u32_b32 %0, -1, %0" : "=v"(l_)); return l_; }())
#define LEADER() (wave_s == 0 && LANE_ID() == 0)
    for (int u = threadIdx.x; u < (LDS_BYTES - MISC_OFF) / 4; u += 512) MISC[u] = 0u;
    __syncthreads();
    XcdBarrier bar = xcd_barrier_post((unsigned*)(args.ws + WS_CTL) + CW_BAR, MISC, LEADER());
#define PH_LOCALS int lane_ = LANE_ID(); asm volatile("" : "+v"(lane_)); const int lane = lane_, wave = wave_s, tid = wave_s * 64 + lane_; \
    const int gw = bx * 8 + wave, NGW = G * 8, gt = bx * 512 + tid, NGT = G * 512; size_t z_; asm volatile("s_mov_b64 %0, 0" : "=s"(z_)); unsigned char* ws = args.ws + z_; \
    (void)lane; (void)tid; (void)gw; (void)NGW; (void)gt; (void)NGT; (void)ws;
#define W_(T, off) ((T*)(ws + (off)))

    {
        PH_LOCALS
        bf16_t* HB = W_(bf16_t, WS_HB);
        LAS float* scr = (LAS float*)(lds + wave * 16384);
        const int gwp = wave * G + bx;
        { const float* W = args.in[I_WIN];
          for (int it = gwp; it < 16 * 72; it += NGW) { const int kb = it / 72, nb = it % 72;
              transpose_item(W, 1024, 2112, W_(bf16_t, WS_WIN), scr, kb, nb * 32, lane, nullptr, [](int n) { return n < 512 ? n : (n < 2048 ? n + 64 : (n < 2112 ? 512 + ((n - 2048) >> 1) + 32 * ((n - 2048) & 1) : -1)); }); } }
        { const float* W = args.in[I_WUQ];
          for (int it = (gwp + NGW - 1664) % NGW; it < 4 * 24; it += NGW) { const int kb = it / 24, nb = it % 24;
              transpose_item(W, 256, 768, W_(bf16_t, WS_WUQ), scr, kb, nb * 32, lane, args.in[I_QG], [](int n) { const int hd = n / 192, d = n % 192; return d < 128 ? n : hd * 192 + 128 + ((d - 128) >> 1) + 32 * ((d - 128) & 1); }); } }
        { const float* W = args.in[I_WUKV];
          for (int it = (gwp + NGW - 1760) % NGW; it < 4 * 32; it += NGW) { const int kb = it / 32, nb = it % 32;
              transpose_item(W, 256, 1024, W_(bf16_t, WS_WUKV), scr, kb, nb * 32, lane, args.in[I_KVG], [](int n) { const int v = n >> 9, hd = (n & 511) >> 7, j = n & 127; return hd * 256 + v * 128 + j; }); } }
        { const float* W = args.in[I_WO];
          for (int it = (gwp + NGW - 1152) % NGW; it < 16 * 32; it += NGW) { const int kb = it / 32, nb = it % 32; transpose_item(W, 1024, 1024, W_(bf16_t, WS_WO), scr, kb, nb * 32, lane, kb < 8 ? args.in[I_MLAG] : args.in[I_SBG] - 512, [](int n) { return n; }); } }
        { const float* W = args.in[I_WR];
          for (int it = (gwp + NGW - 1888) % NGW; it < 16 * 8; it += NGW) { const int kb = it / 8, nb = it % 8; transpose_item(W, 1024, 32, W_(bf16_t, WS_WR), scr, kb, nb * 32, lane, args.in[I_LN1G], [](int n) { return n < 32 ? n : -1; }); } }
        { const float* x = args.in[I_X];
          { size_t i = (size_t)gt; const size_t total = (size_t)MX * 128, st8 = (size_t)NGT;
#pragma unroll 1
            for (; i + 7 * st8 < total; i += 8 * st8) {
                f32x4 a[8], b[8];
#pragma unroll
                for (int k = 0; k < 8; ++k) { a[k] = __builtin_nontemporal_load((const f32x4*)(x + (i + k * st8) * 8)); b[k] = __builtin_nontemporal_load((const f32x4*)(x + (i + k * st8) * 8 + 4)); }
#pragma unroll
                for (int k = 0; k < 8; ++k) *(u32x4*)(HB + (i + k * st8) * 8) = pack8(a[k], b[k], 1.f);
            }
            for (; i < total; i += st8) { const f32x4 a = __builtin_nontemporal_load((const f32x4*)(x + i * 8)), b = __builtin_nontemporal_load((const f32x4*)(x + i * 8 + 4)); *(u32x4*)(HB + i * 8) = pack8(a, b, 1.f); } }
          const float* mt = args.in[I_META];
          for (int i = gt; i < 256 * 128; i += NGT) { u32x4 w = (u32x4){0u, 0u, 0u, 0u}; if (i < NMETA * 128) { const f32x4 a = *(const f32x4*)(mt + (size_t)i * 8), b = *(const f32x4*)(mt + (size_t)i * 8 + 4); w = pack8(a, b, 1.f); }
              *(u32x4*)(HB + (size_t)MX * 1024 + (size_t)i * 8) = w; } }
        { float* ROPE = W_(float, WS_ROPE);
          for (int i = gt; i < NPOS * 32; i += NGT) { const int pos = i >> 5, k = i & 31; const float ang = (float)pos * args.freq[k]; float c, sn; sincos_acc(ang, c, sn); ROPE[(size_t)i * 2] = c; ROPE[(size_t)i * 2 + 1] = sn; } }
    }
    xcd_barrier(bar, LEADER());

    {
        PH_LOCALS
        { const u32x4 z = (u32x4){0u, 0u, 0u, 0u};
          for (int i = gt; i < 48 * 96; i += NGT) ((u32x4*)(W_(bf16_t, R_K) + (size_t)(MX + 16) * 768))[i] = z;
          for (int i = gt; i < 48 * 64; i += NGT) { ((u32x4*)(W_(bf16_t, R_V) + (size_t)(MX + 16) * 512))[i] = z; ((u32x4*)(W_(bf16_t, R_SBK) + (size_t)(MX + 16) * 512))[i] = z; ((u32x4*)(W_(bf16_t, R_SBV) + (size_t)(MX + 16) * 512))[i] = z; } }
        pg8::SchedDense S; S.init(W_(bf16_t, WS_HB), W_(bf16_t, WS_WIN), 1024, 1024, MX, 2304, G, bx);
        EpiInProj E{ws, W_(float, WS_ROPE)};
        pg8::gemm_phase<EpiInProj, pg8::SchedDense, true>(lds, 2048, S, E, tid);
        for (int task = bx; task < 84; task += G) meta_inproj(ws, task, lane, wave, lds);
    }
    xcd_barrier(bar, LEADER());

    {
        PH_LOCALS
        pg8::SchedDense S; S.init(W_(bf16_t, R_CQ), W_(bf16_t, WS_WUQ), 256, 256, MX, 768, G, bx);
        EpiQ E{W_(bf16_t, R_Q)};
        pg8::gemm_phase<EpiQ, pg8::SchedDense, true>(lds, 512, S, E, tid);
    }
    {
        PH_LOCALS
        SchedKV S; S.init(W_(bf16_t, R_CKV), W_(bf16_t, WS_WUKV), 256, 256, MX, 1024, G, bx); S.ssq = W_(float, WS_SSQKV);
        EpiKV E{W_(bf16_t, R_K), W_(bf16_t, R_V), lds};
        pg8::gemm_phase<EpiKV, SchedKV, true, false, false, false, 4>(lds, 512, S, E, tid);
        for (int task = bx; task < 64; task += G) meta_kvup(ws, task, lane, wave, lds);
    }
    xcd_barrier(bar, LEADER());

    {
        PH_LOCALS
        const int vcu = (G % 8 == 0) ? (bx % 8) * (G / 8) + bx / 8 : bx;
        const int nmla = (G == 256) ? 4 : (1024 - bx + G - 1) / G;
#pragma unroll 1
        for (int i = 0; i < nmla; ++i) {
            int b, h, qb;
            if (G == 256) { const int bh = vcu >> 3, sx = vcu & 7; b = bh >> 2; h = bh & 3; qb = (i == 0) ? sx : (i == 1) ? 15 - sx : (i == 2) ? 16 + sx : 31 - sx; }
            else { const int u = bx + i * G; b = u >> 7; h = (u >> 5) & 3; qb = u & 31; }
            att::mla_unit(b, h, qb, W_(bf16_t, R_Q), W_(bf16_t, R_K), W_(bf16_t, R_V), W_(bf16_t, R_O), W_(float, R_SSQO), W_(float, WS_SSQQ), W_(float, WS_ROPE), lds, tid);
        }
#pragma unroll 1
        for (int u = vcu; u < 2048; u += G) att::sb_unit(u >> 8, (u >> 5) & 7, u & 31, W_(bf16_t, R_SBQ), W_(bf16_t, R_SBK), W_(bf16_t, R_SBV), W_(bf16_t, R_O), W_(float, R_SSQO), lds, tid);
        for (int e = bx; e < NE; e += G) { const float* W = args.in[I_WR]; const float* g1 = args.in[I_LN1G]; const float* b1 = args.in[I_LN1B];
            const float w0 = W[tid * 32 + e], w1 = W[(tid + 512) * 32 + e]; const float ga = g1[tid], gb = g1[tid + 512], ba = b1[tid], bc = b1[tid + 512];
            const float cs = bf_lo(cvtpk(ga * w0, 0.f)) + bf_lo(cvtpk(gb * w1, 0.f)), cb = ba * w0 + bc * w1;
            LAS float* red = (LAS float*)lds; __syncthreads(); red[tid] = cs; red[512 + tid] = cb; __syncthreads();
            if (tid < 32) { float a1 = 0.f, a2 = 0.f;
#pragma unroll
                for (int q = 0; q < 16; ++q) { a1 += red[tid * 16 + q]; a2 += red[512 + tid * 16 + q]; }
                red[1024 + tid] = a1; red[1056 + tid] = a2; }
            __syncthreads();
            if (tid == 0) { float a1 = 0.f, a2 = 0.f; for (int q = 0; q < 32; ++q) { a1 += red[1024 + q]; a2 += red[1056 + q]; } W_(float, WS_RC)[e] = a1; W_(float, WS_RC)[32 + e] = a2 + args.in[I_BR][e]; }
            __syncthreads(); }
        {
            unsigned* qh = W_(unsigned, WS_CTL) + CW_Q; volatile LAS unsigned* qs = (volatile LAS unsigned*)(lds + MISC_OFF + 128);
            LAS float* scr = (LAS float*)(lds + wave * 16384);
            __syncthreads();
            if (tid == 0) qs[0] = __hip_atomic_fetch_add(qh, 32u, __ATOMIC_RELAXED, __HIP_MEMORY_SCOPE_AGENT);
            __syncthreads();
            int base = __builtin_amdgcn_readfirstlane((int)qs[0]), g = 0;
#pragma unroll 1
            while (base < CV_NI) {
                unsigned nv = 0u; if (tid == 0) { const unsigned inc_ = 32u; asm volatile("global_atomic_add %0, %1, %2, off sc0" : "=&v"(nv) : "v"(qh), "v"(inc_) : "memory"); }
                convert_experts(args.in[I_WG], args.in[I_WU], args.in[I_WD], ws, scr, lane, base + wave, 8, 4);
                if (tid == 0) { asm volatile("s_waitcnt vmcnt(0)" : "+v"(nv) :: "memory"); qs[(g & 1) ^ 1] = nv; }
                __syncthreads();
                base = __builtin_amdgcn_readfirstlane((int)qs[(g & 1) ^ 1]); ++g;
            }
        }
    }
    xcd_barrier(bar, LEADER());

    {
        PH_LOCALS
        SchedWo S; S.init(W_(bf16_t, R_O), W_(bf16_t, WS_WO), 1024, 1024, MX, 1024, G, bx); S.ssqo = W_(float, R_SSQO); S.ldsb = lds;
        EpiWoLN E{W_(bf16_t, R_S), W_(bf16_t, WS_HB), W_(float, R_LNST), lds};
        pg8::gemm_phase<EpiWoLN, SchedWo, true, false, false, true>(lds, 2048, S, E, tid);
    }
    xcd_barrier(bar, LEADER());

    {
        PH_LOCALS
#pragma unroll 1
        for (int p = bx; p < MX / 256; p += G) {
            float mean_l, rstd_l;
            { const f32x4* sp = (const f32x4*)(W_(float, R_LNST) + (size_t)(p * 256 + wave * 32 + (lane & 31)) * 32); float a1 = 0.f, a2 = 0.f;
#pragma unroll
              for (int q = 0; q < 8; ++q) { const f32x4 t = sp[q]; a1 += t[0] + t[2]; a2 += t[1] + t[3]; }
              mean_l = a1 * (1.f / 1024.f); const float var = fmaxf(a2 * (1.f / 1024.f) - mean_l * mean_l, 0.f); rstd_l = 1.f / sqrtf(var + LN_EPS);
              if (lane < 32) { ((LAS f32x2*)(lds + MR_OFF))[wave * 32 + lane] = (f32x2){mean_l, rstd_l}; ((f32x2*)W_(float, R_MR))[p * 256 + wave * 32 + lane] = (f32x2){mean_l, rstd_l}; } }
            __syncthreads();
            {
                SchedOne S; S.init(W_(bf16_t, R_S), W_(bf16_t, WS_WR), 1024, 1024, MX, 256, G, bx); S.p = p;
                EpiRouter E{W_(float, WS_RC), W_(unsigned, WS_CTL), W_(unsigned, WS_TOKBIN), W_(unsigned, WS_SLOT), W_(float, WS_GATEV)};
                pg8::gemm_phase<EpiRouter, SchedOne, false>(lds, 2048, S, E, tid);
            }
            __syncthreads();
            {
                unsigned char* H1Q = W_(unsigned char, WS_H1Q); const bf16_t* SG = W_(bf16_t, R_S);
                const float* g = args.in[I_LN1G]; const float* bb = args.in[I_LN1B];
                f32x4 gv[4], bv[4];
#pragma unroll
                for (int j = 0; j < 4; ++j) { gv[j] = *(const f32x4*)(g + lane * 8 + 512 * (j >> 1) + 4 * (j & 1)); bv[j] = *(const f32x4*)(bb + lane * 8 + 512 * (j >> 1) + 4 * (j & 1)); }
#pragma unroll 4
                for (int i = 0; i < 32; ++i) {
                    const int rl = wave * 32 + i; const size_t ro = (size_t)(p * 256 + rl) * 1024 + lane * 8;
                    const u32x4 w0 = *(const u32x4*)(SG + ro), w1 = *(const u32x4*)(SG + ro + 512);
                    const float mean = __shfl(mean_l, i), rstd = __shfl(rstd_l, i);
                    const f32x4 y0 = ((f32x4){bf_lo(w0.x), bf_hi(w0.x), bf_lo(w0.y), bf_hi(w0.y)} - mean) * rstd * gv[0] + bv[0], y1 = ((f32x4){bf_lo(w0.z), bf_hi(w0.z), bf_lo(w0.w), bf_hi(w0.w)} - mean) * rstd * gv[1] + bv[1];
                    const f32x4 y2 = ((f32x4){bf_lo(w1.x), bf_hi(w1.x), bf_lo(w1.y), bf_hi(w1.y)} - mean) * rstd * gv[2] + bv[2], y3 = ((f32x4){bf_lo(w1.z), bf_hi(w1.z), bf_lo(w1.w), bf_hi(w1.w)} - mean) * rstd * gv[3] + bv[3];
                    u32x2 q0, q1; q0.x = pk4_fp8(y0[0], y0[1], y0[2], y0[3]); q0.y = pk4_fp8(y1[0], y1[1], y1[2], y1[3]); q1.x = pk4_fp8(y2[0], y2[1], y2[2], y2[3]); q1.y = pk4_fp8(y3[0], y3[1], y3[2], y3[3]);
                    *(u32x2*)(H1Q + ro) = q0; *(u32x2*)(H1Q + ro + 512) = q1;
                }
            }
            __syncthreads();
        }
    }
    xcd_barrier(bar, LEADER());

    MoeTab T; T.cnt = (LAS int*)(lds + MISC_OFF + 256); T.ts = (LAS int*)(lds + MISC_OFF + 512); T.te = lds + MISC_OFF + 2048;
    if (wave_s == 0) {
        const int l = LANE_ID(); unsigned* ctl = (unsigned*)(args.ws + WS_CTL);
        int c = 0; if (l < NE) c = (int)__hip_atomic_load(ctl + CW_CNT + 64 * l, __ATOMIC_RELAXED, __HIP_MEMORY_SCOPE_AGENT);
        const int tl = (c + 255) >> 8; int incl = tl;
#pragma unroll
        for (int o = 1; o < 32; o <<= 1) { const int v = __shfl_up(incl, o); if (l >= o) incl += v; }
        if (l < NE) { T.cnt[l] = c; T.ts[l] = incl - tl; }
        if (l == NE - 1) T.ts[NE] = incl;
    }
    __syncthreads();
    { const int nt_ = T.ts[NE]; for (int t = wave_s * 64 + LANE_ID(); t < nt_; t += 512) { int e = 0; for (int k = 1; k < NE; ++k) if (t >= T.ts[k]) e = k; T.te[t] = (unsigned char)e; } }
    __syncthreads();

    {
        PH_LOCALS
        SchedGU S{(const char*)W_(unsigned char, WS_H1Q), (const char*)W_(unsigned char, WS_WGU), W_(unsigned, WS_TOKBIN), T, G, bx, T.ts[NE], args.in[I_BG], args.in[I_BU]};
        EpiGU E{lds, (unsigned char*)args.out, ws};
        pg8::gemm_phase<EpiGU, SchedGU, true, true, true, false, 1>(lds, 1024, S, E, tid);
    }
    xcd_barrier(bar, LEADER());

    {
        PH_LOCALS
        SchedDN S{(unsigned char*)args.out, ws, (const char*)W_(unsigned char, WS_WDN), T, G, bx, T.ts[NE], args.in[I_BD]};
        EpiDN E{lds, ws};
        pg8::gemm_phase<EpiDN, SchedDN, true, false, true, false, 1>(lds, 1024, S, E, tid);
    }
    xcd_barrier(bar, LEADER());

    {
        PH_LOCALS
        const bf16_t* HB = W_(bf16_t, R_S); const unsigned* SLOT = W_(unsigned, WS_SLOT); const float* GATEV = W_(float, WS_GATEV); const f32x2* MR = (const f32x2*)W_(float, R_MR);
        const float* g = args.in[I_LN2G]; const float* bb = args.in[I_LN2B];
        f32x4 gv[4], bv[4], g1v[4], b1v[4];
#pragma unroll
        for (int j = 0; j < 4; ++j) { gv[j] = *(const f32x4*)(g + lane * 4 + 256 * j); bv[j] = *(const f32x4*)(bb + lane * 4 + 256 * j); g1v[j] = *(const f32x4*)(args.in[I_LN1G] + lane * 4 + 256 * j) * DN_ALPHA; b1v[j] = *(const f32x4*)(args.in[I_LN1B] + lane * 4 + 256 * j) * DN_ALPHA; }
#pragma unroll 2
        for (int m = gw; m < MX; m += NGW) {
            const u32x4 sl = *(const u32x4*)(SLOT + (size_t)m * 4); const f32x4 gt4 = *(const f32x4*)(GATEV + (size_t)m * 4); const f32x2 mr = MR[m];
            const u32x2* hr = (const u32x2*)(HB + (size_t)m * 1024) + lane;
            f32x4 v[4];
#pragma unroll
            for (int j = 0; j < 4; ++j) { const u32x2 w = __builtin_nontemporal_load(hr + 64 * j); v[j] = (((f32x4){bf_lo(w.x), bf_hi(w.x), bf_lo(w.y), bf_hi(w.y)} - mr[0]) * mr[1]) * g1v[j] + b1v[j]; }
#pragma unroll
            for (int k = 0; k < 4; ++k) { const unsigned sk = sl[k]; const int e = (int)(sk >> 20), pos = (int)(sk & 0xfffffu); const int tile = T.ts[e] + (pos >> 8);
                const unsigned* yr = (const unsigned*)(y_tile_ptr(ws, tile) + (size_t)(pos & 255) * 1024) + lane; const float gk = gt4[k];
#pragma unroll
                for (int j = 0; j < 4; ++j) v[j] += unpk4_fp8(__builtin_nontemporal_load(yr + 64 * j)) * gk; }
            float s = 0.f;
#pragma unroll
            for (int j = 0; j < 4; ++j) s += (v[j][0] + v[j][1]) + (v[j][2] + v[j][3]);
            const float mean = wave_sum(s) * (1.f / 1024.f); float s2 = 0.f;
#pragma unroll
            for (int j = 0; j < 4; ++j) { v[j] = v[j] - mean; s2 += (v[j][0] * v[j][0] + v[j][1] * v[j][1]) + (v[j][2] * v[j][2] + v[j][3] * v[j][3]); }
            const float rstd = 1.f / sqrtf(wave_sum(s2) * (1.f / 1024.f) + LN_EPS);
            f32x4* orow = (f32x4*)(args.out + (size_t)m * 1024) + lane;
#pragma unroll
            for (int j = 0; j < 4; ++j) __builtin_nontemporal_store(v[j] * rstd * gv[j] + bv[j], orow + 64 * j);
        }
    }
}

extern "C" void kernel_launch(void* const* d_in, const int* in_sizes, int n_in, void* d_out, int out_size, void* d_ws, size_t ws_size, hipStream_t stream) {
    static int grid = 0;
    static float freq[32];
    if (grid == 0) {
        if (n_in != 22 || in_sizes[0] != MX * DM || out_size != MX * DM || ws_size < WS_END) { fprintf(stderr, "kernel_launch: unexpected shapes (n_in %d, in0 %d, out %d, ws %zu)\n", n_in, n_in > 0 ? in_sizes[0] : -1, out_size, ws_size); grid = -1; return; }
        int dev = 0, cus = 0, per_cu = 0;
        if (hipGetDevice(&dev) != hipSuccess || hipDeviceGetAttribute(&cus, hipDeviceAttributeMultiprocessorCount, dev) != hipSuccess) { grid = -1; return; }
        if (hipFuncSetAttribute((const void*)fwd, hipFuncAttributeMaxDynamicSharedMemorySize, LDS_BYTES) != hipSuccess) { fprintf(stderr, "kernel_launch: hipFuncSetAttribute failed\n"); grid = -1; return; }
        if (hipOccupancyMaxActiveBlocksPerMultiprocessor(&per_cu, (const void*)fwd, 512, LDS_BYTES) != hipSuccess || per_cu < 1) fprintf(stderr, "kernel_launch: occupancy query reports %d\n", per_cu);
        (void)hipGetLastError();
        grid = cus;
        for (int i = 0; i < 32; ++i) freq[i] = (float)pow(10000.0, -(double)i / 32.0);
    }
    if (grid < 0) return;
    if (hipMemsetAsync((char*)d_ws + WS_CTL, 0, CTL_ZERO_BYTES, stream) != hipSuccess) return;
    Args a{};
    for (int i = 0; i < 22; ++i) a.in[i] = (const float*)d_in[i];
    a.out = (float*)d_out; a.ws = (unsigned char*)d_ws;
    for (int i = 0; i < 32; ++i) a.freq[i] = freq[i];
    hipLaunchKernelGGL(fwd, dim3(grid), dim3(512), LDS_BYTES, stream, a);
}
```
